# Optimizing an MI355X kernel written in HIP

```python
import math
import jax
import jax.numpy as jnp
from jax import lax
import numpy as np

D_MODEL = 2048
BATCH = 4
SEQ = 2048
DEPTH = 4

HEAD_DIM = 128
N_GROUPS = 4
HEADS_PER_GROUP = D_MODEL // (N_GROUPS * HEAD_DIM)
GROUP_WIDTH = HEADS_PER_GROUP * HEAD_DIM
DIFF_QK_DIM = HEAD_DIM // 2
Q_BLOCK = 128
MOBA_BLOCK = 256
MOBA_TOPK = 3
MOBA_Q_CHUNK = 32
ROPE_THETA = 10000.0
NORM_EPS = 1e-6
DIFF_SUBLN_EPS = 1e-5
FFN_HIDDEN = -(-8 * D_MODEL // (3 * 256)) * 256
SPLIT_SIZES = (GROUP_WIDTH, GROUP_WIDTH, GROUP_WIDTH, HEADS_PER_GROUP,
               GROUP_WIDTH, GROUP_WIDTH, GROUP_WIDTH,
               GROUP_WIDTH, GROUP_WIDTH, GROUP_WIDTH,
               GROUP_WIDTH, GROUP_WIDTH, GROUP_WIDTH)
IN_COLS = sum(SPLIT_SIZES)

kernel_name = 'hybrid_parallel_heads_fox_moba_diff_stickbreak'


def _rmsnorm(x, g, eps=NORM_EPS):
    xf = x.astype(jnp.float32)
    y = xf * lax.rsqrt(jnp.mean(xf * xf, axis=-1, keepdims=True) + eps)
    return (y * g.astype(jnp.float32)).astype(x.dtype)


def _rope_tables(s_len, dim):
    inv = 1.0 / (ROPE_THETA ** (jnp.arange(0, dim, 2, dtype=jnp.float32) / dim))
    ang = jnp.arange(s_len, dtype=jnp.float32)[:, None] * inv[None, :]
    return jnp.cos(ang), jnp.sin(ang)


def _apply_rope(x, cos, sin):
    x1, x2 = jnp.split(x.astype(jnp.float32), 2, axis=-1)
    out = jnp.concatenate([x1 * cos - x2 * sin, x2 * cos + x1 * sin], axis=-1)
    return out.astype(x.dtype)


def _heads(a):
    b, s, w = a.shape
    return a.reshape(b, s, w // HEAD_DIM, HEAD_DIM).transpose(0, 2, 1, 3)


def _merge(a):
    b, h, s, d = a.shape
    return a.transpose(0, 2, 1, 3).reshape(b, s, h * d)


def _to_blocks(a, blk):
    b, h, s, d = a.shape
    return a.reshape(b, h, s // blk, blk, d).transpose(2, 0, 1, 3, 4)


def _from_blocks(o):
    n, b, h, blk, d = o.shape
    return o.transpose(1, 2, 0, 3, 4).reshape(b, h, n * blk, d)


def _split_cols(z):
    points = [int(p) for p in np.cumsum(SPLIT_SIZES)[:-1]]
    return jnp.split(z, points, axis=-1)


def _forgetting_attention(q, k, v, f_logit):
    s_len, d = q.shape[2], q.shape[3]
    nq = s_len // Q_BLOCK
    c = jnp.cumsum(jax.nn.log_sigmoid(f_logit.astype(jnp.float32)), axis=-1)
    kpos = jnp.arange(s_len)
    scale = d ** -0.5

    def one_block(args):
        qb, cb, q0 = args
        qpos = q0 + jnp.arange(Q_BLOCK)
        logits = jnp.einsum('bhqd,bhkd->bhqk', qb, k).astype(jnp.float32) * scale
        logits = logits + cb[..., :, None] - c[..., None, :]
        logits = jnp.where(kpos[None, :] <= qpos[:, None], logits, -jnp.inf)
        p = jax.nn.softmax(logits, axis=-1)
        return jnp.einsum('bhqk,bhkd->bhqd', p.astype(v.dtype), v)

    c_blocks = c.reshape(c.shape[0], c.shape[1], nq, Q_BLOCK).transpose(2, 0, 1, 3)
    out = lax.map(one_block, (_to_blocks(q, Q_BLOCK), c_blocks, jnp.arange(nq) * Q_BLOCK))
    return _from_blocks(out)


def _moba_attention(q, k, v):
    b, h, s_len, d = q.shape
    n_kb = -(-s_len // MOBA_BLOCK)
    pad = n_kb * MOBA_BLOCK - s_len
    kb = jnp.pad(k, ((0, 0), (0, 0), (0, pad), (0, 0))).reshape(b, h, n_kb, MOBA_BLOCK, d)
    vb = jnp.pad(v, ((0, 0), (0, 0), (0, pad), (0, 0))).reshape(b, h, n_kb, MOBA_BLOCK, d)
    k_mean = jnp.mean(kb.astype(jnp.float32), axis=3)
    top_k = min(MOBA_TOPK, n_kb)
    n_sel = top_k + 1
    blk_ids = jnp.arange(n_kb)
    offs = jnp.arange(MOBA_BLOCK)
    bi = jnp.arange(b)[:, None, None, None]
    hi = jnp.arange(h)[None, :, None, None]
    scale = d ** -0.5

    def one_chunk(args):
        qc, q0 = args
        qpos = q0 + jnp.arange(MOBA_Q_CHUNK)
        own = qpos // MOBA_BLOCK
        own_b = jnp.broadcast_to(own[None, None, :, None], (b, h, MOBA_Q_CHUNK, 1))
        gate = jnp.einsum('bhqd,bhnd->bhqn', qc.astype(jnp.float32), k_mean)
        gate = jnp.where(blk_ids[None, :] < own[:, None], gate, -jnp.inf)
        _, top = lax.top_k(gate, top_k)
        sel = jnp.concatenate([top, own_b], axis=-1)
        slot_ok = jnp.concatenate([top < own_b, jnp.ones_like(own_b, dtype=bool)], axis=-1)
        k_sel = kb[bi, hi, sel]
        v_sel = vb[bi, hi, sel]
        logits = jnp.einsum('bhqd,bhqnkd->bhqnk', qc, k_sel).astype(jnp.float32) * scale
        kpos = sel[..., None] * MOBA_BLOCK + offs
        mask = slot_ok[..., None] & (kpos <= qpos[None, None, :, None, None])
        logits = jnp.where(mask, logits, -jnp.inf).reshape(b, h, MOBA_Q_CHUNK, n_sel * MOBA_BLOCK)
        p = jax.nn.softmax(logits, axis=-1).reshape(b, h, MOBA_Q_CHUNK, n_sel, MOBA_BLOCK)
        return jnp.einsum('bhqnk,bhqnkd->bhqd', p.astype(v_sel.dtype), v_sel)

    nq = s_len // MOBA_Q_CHUNK
    out = lax.map(one_chunk, (_to_blocks(q, MOBA_Q_CHUNK), jnp.arange(nq) * MOBA_Q_CHUNK))
    return _from_blocks(out)


def _differential_attention(q, k, v, lam, lam_init, g_sub, cos, sin):
    s_len = q.shape[2]
    nq = s_len // Q_BLOCK
    q1 = _apply_rope(q[..., :DIFF_QK_DIM], cos, sin)
    q2 = _apply_rope(q[..., DIFF_QK_DIM:], cos, sin)
    k1 = _apply_rope(k[..., :DIFF_QK_DIM], cos, sin)
    k2 = _apply_rope(k[..., DIFF_QK_DIM:], cos, sin)
    kpos = jnp.arange(s_len)
    scale = DIFF_QK_DIM ** -0.5

    def one_block(args):
        q1b, q2b, q0 = args
        qpos = q0 + jnp.arange(Q_BLOCK)
        causal = kpos[None, :] <= qpos[:, None]
        l1 = jnp.einsum('bhqd,bhkd->bhqk', q1b, k1).astype(jnp.float32) * scale
        l2 = jnp.einsum('bhqd,bhkd->bhqk', q2b, k2).astype(jnp.float32) * scale
        p1 = jax.nn.softmax(jnp.where(causal, l1, -jnp.inf), axis=-1)
        p2 = jax.nn.softmax(jnp.where(causal, l2, -jnp.inf), axis=-1)
        p = p1 - lam * p2
        return jnp.einsum('bhqk,bhkd->bhqd', p.astype(v.dtype), v)

    out = lax.map(one_block, (_to_blocks(q1, Q_BLOCK), _to_blocks(q2, Q_BLOCK), jnp.arange(nq) * Q_BLOCK))
    out = _from_blocks(out)
    return _rmsnorm(out, g_sub, DIFF_SUBLN_EPS) * (1.0 - lam_init)


def _stick_breaking_attention(q, k, v):
    s_len, d = q.shape[2], q.shape[3]
    nq = s_len // Q_BLOCK
    kpos = jnp.arange(s_len)
    scale = d ** -0.5

    def one_block(args):
        qb, q0 = args
        qpos = q0 + jnp.arange(Q_BLOCK)
        z = jnp.einsum('bhqd,bhkd->bhqk', qb, k).astype(jnp.float32) * scale
        strict = kpos[None, :] < qpos[:, None]
        log_beta = jax.nn.log_sigmoid(z)
        log_1m = jnp.where(strict, jax.nn.log_sigmoid(-z), 0.0)
        between = lax.cumsum(log_1m, axis=3, reverse=True) - log_1m
        a = jnp.where(strict, jnp.exp(log_beta + between), 0.0)
        return jnp.einsum('bhqk,bhkd->bhqd', a.astype(v.dtype), v)

    out = lax.map(one_block, (_to_blocks(q, Q_BLOCK), jnp.arange(nq) * Q_BLOCK))
    return _from_blocks(out)


def setup_inputs(seed: int = 0) -> dict:
    key = jax.random.key(seed)
    ks = jax.random.split(key, 16)
    f32 = jnp.float32

    def nrm(k, shape, scale):
        return jax.random.normal(k, shape, f32) * scale

    return {
        'x': nrm(ks[0], (BATCH, SEQ, D_MODEL), 1.0),
        'w_in': nrm(ks[1], (DEPTH, D_MODEL, IN_COLS), D_MODEL ** -0.5),
        'b_fgate': nrm(ks[2], (DEPTH, HEADS_PER_GROUP), 0.1),
        'w_out': nrm(ks[3], (DEPTH, D_MODEL, D_MODEL), D_MODEL ** -0.5),
        'diff_lq1': nrm(ks[4], (DEPTH, DIFF_QK_DIM), 0.1),
        'diff_lk1': nrm(ks[5], (DEPTH, DIFF_QK_DIM), 0.1),
        'diff_lq2': nrm(ks[6], (DEPTH, DIFF_QK_DIM), 0.1),
        'diff_lk2': nrm(ks[7], (DEPTH, DIFF_QK_DIM), 0.1),
        'diff_subln': 1.0 + nrm(ks[8], (DEPTH, HEAD_DIM), 0.02),
        'attn_norm': 1.0 + nrm(ks[9], (DEPTH, D_MODEL), 0.02),
        'w_gate': nrm(ks[10], (DEPTH, D_MODEL, FFN_HIDDEN), D_MODEL ** -0.5),
        'w_up': nrm(ks[11], (DEPTH, D_MODEL, FFN_HIDDEN), D_MODEL ** -0.5),
        'w_down': nrm(ks[12], (DEPTH, FFN_HIDDEN, D_MODEL), FFN_HIDDEN ** -0.5),
        'ffn_norm': 1.0 + nrm(ks[13], (DEPTH, D_MODEL), 0.02),
        'final_norm': 1.0 + nrm(ks[14], (D_MODEL,), 0.02),
    }


def reference(x, w_in, b_fgate, w_out, diff_lq1, diff_lk1, diff_lq2, diff_lk2, diff_subln,
              attn_norm, w_gate, w_up, w_down, ffn_norm, final_norm):
    s_len = x.shape[1]
    cos_full, sin_full = _rope_tables(s_len, HEAD_DIM)
    cos_half, sin_half = _rope_tables(s_len, DIFF_QK_DIM)
    for l in range(DEPTH):
        h = _rmsnorm(x, attn_norm[l])
        z = jnp.einsum('bsd,dc->bsc', h, w_in[l])
        (fq, fk, fv, fg, mq, mk, mv, dq, dk, dv, sq, sk, sv) = _split_cols(z)

        fox = _forgetting_attention(_heads(fq), _heads(fk), _heads(fv),
                                    (fg + b_fgate[l]).transpose(0, 2, 1))

        moba = _moba_attention(_apply_rope(_heads(mq), cos_full, sin_full),
                               _apply_rope(_heads(mk), cos_full, sin_full), _heads(mv))

        lam_init = 0.8 - 0.6 * math.exp(-0.3 * l)
        lam = (jnp.exp(jnp.sum(diff_lq1[l].astype(jnp.float32) * diff_lk1[l].astype(jnp.float32)))
               - jnp.exp(jnp.sum(diff_lq2[l].astype(jnp.float32) * diff_lk2[l].astype(jnp.float32)))
               + lam_init)
        diff = _differential_attention(_heads(dq), _heads(dk), _heads(dv), lam, lam_init,
                                       diff_subln[l], cos_half, sin_half)

        sb = _stick_breaking_attention(_heads(sq), _heads(sk), _heads(sv))

        mixed = jnp.concatenate([_merge(fox), _merge(moba), _merge(diff), _merge(sb)], axis=-1)
        x = x + jnp.einsum('bsc,cd->bsd', mixed, w_out[l])

        h = _rmsnorm(x, ffn_norm[l])
        act = jax.nn.silu(jnp.einsum('bsd,df->bsf', h, w_gate[l])) * jnp.einsum('bsd,df->bsf', h, w_up[l])
        x = x + jnp.einsum('bsf,fd->bsd', act, w_down[l])
    return _rmsnorm(x, final_norm)
```

```cpp
#include <hip/hip_runtime.h>
#include <hip/hip_cooperative_groups.h>
#include <cstdio>
#include <cstdint>
#include <cmath>
namespace cg = cooperative_groups;
#define DI __device__ __forceinline__
constexpr int M_TOK = 8192, DM = 2048, SEQ = 2048, ZC = 6144, FF = 5632, WIN_LD = 6148;
DI int tid_opaque() { int t = threadIdx.x; asm volatile("" : "+v"(t)); return t; }
namespace pg8 {
#define PG8_LAS __attribute__((address_space(3)))
typedef unsigned short bf16_t;
typedef short bf16x8 __attribute__((ext_vector_type(8)));
typedef float f32x4 __attribute__((ext_vector_type(4)));
typedef unsigned u32x4 __attribute__((ext_vector_type(4)));
constexpr int BM = 256, BK = 64, HALF = 128, HTB = HALF * BK * 2  , STAGE_BYTES = 8 * HTB, NXCD = 8, WGM = 4;

__host__ __device__ __forceinline__ int lds_byte(int r, int c) { const int st = (r >> 4) * 2 + (c >> 5), rr = r & 15, cc = c & 31, ob = rr * 64 + cc * 2; return st * 1024 + (ob ^ (((ob >> 9) & 1) << 5)); }
__host__ __device__ __forceinline__ void stage_rc(int b, int& R, int& C) { const int st = b / 1024, sb = b % 1024, swz = sb ^ (((sb >> 9) & 1) << 5); R = (st >> 1) * 16 + swz / 64; C = (st & 1) * 32 + (swz % 64) / 2; }
__host__ __device__ __forceinline__ int perm32(int rho) { const int n = rho >> 4, i = rho & 15; return 8 * (i >> 2) + 4 * n + (i & 3); }

struct Unit { int pm, pn; };
struct Gemm { const bf16_t* A; const bf16_t* Bt; int M, N, K; };

struct StaticOrder {
    int nM, nN, nwg, G, c;
    __host__ __device__ void init(int M, int N, int G_, int c_) { nM = M / BM; nN = N / BM; nwg = nM * nN; G = G_; c = c_; }
    __host__ __device__ bool next(int i, Unit& u) const {
        const long L = (long)i * G + c; if (L >= nwg) return false;
        int wgid = (int)L; { const int q = nwg / NXCD, r = nwg % NXCD, xcd = wgid % NXCD, off = wgid / NXCD; wgid = (xcd < r ? xcd * (q + 1) : r * (q + 1) + (xcd - r) * q) + off; }
        const int nig = WGM * nN, gid = wgid / nig, fm = gid * WGM, gsz = (nM - fm) < WGM ? (nM - fm) : WGM;
        u.pm = fm + ((wgid % nig) % gsz); u.pn = (wgid % nig) / gsz; return true;
    }
    __device__ __forceinline__ void a_ready(const Unit&) const {}
    __device__ __forceinline__ void done(const Unit&) const {}
};

typedef float f32x2_t __attribute__((ext_vector_type(2))); typedef __bf16 bf16x2_t __attribute__((ext_vector_type(2)));
__device__ __forceinline__ unsigned cvtpk(float lo, float hi) { f32x2_t v = {lo, hi}; bf16x2_t b = __builtin_convertvector(v, bf16x2_t); return __builtin_bit_cast(unsigned, b); }
__device__ __forceinline__ bf16_t f2bf(float f) { return (bf16_t)(cvtpk(f, 0.f) & 0xffffu); }
struct EpiZ {
    static constexpr bool PERM = true, AFTER_DRAIN = false, INIT_ACC = false;
    bf16_t* z; const float* cosF; const float* sinF; const float* cosH; const float* sinH; unsigned* kinf;
    __device__ __forceinline__ void operator()(const f32x4 (&acc)[2][2][4][2], const Unit& u, int wr, int wc, int fr, int fq) const {
        const int region = u.pn >> 1;
        asm volatile("" : "+v"(fq), "+v"(fr));
        const int rloc = wr * 64 + fr;
        bf16_t* zt = z + (size_t)(u.pm * 256) * 6144 + 256 * u.pn;
        if (region == 3 || region == 4 || region == 6 || region == 7) {
            const bool full = (region < 6);
            const int headin = full ? (wc >> 1) : (wc & 1);
            const int i0 = full ? (32 * (wc & 1) + 8 * fq) : (8 * fq);
            const int c1 = full ? (128 * headin + i0) : (128 * headin + 64 * (wc >> 1) + i0);
            const int c2 = c1 + (full ? 64 : 32);
            const int tw = full ? 64 : 32;
            const float* ct = full ? cosF : cosH; const float* st = full ? sinF : sinH;
#pragma unroll
            for (int ai = 0; ai < 2; ++ai)
#pragma unroll
                for (int m = 0; m < 4; ++m) {
                    const int rr = ai * 128 + m * 16 + rloc; const int pos = (u.pm * 256 + rr) & 2047;
                    const unsigned to = (unsigned)(pos * tw + i0);
                    const unsigned zo = (unsigned)(rr * 6144);
#pragma unroll
                    for (int n = 0; n < 2; ++n) {
                        const f32x4 cc = *(const f32x4*)(ct + to + 4 * n), ss = *(const f32x4*)(st + to + 4 * n);
                        const f32x4 x1 = acc[ai][0][m][n], x2 = acc[ai][1][m][n];
                        const f32x4 y1 = x1 * cc - x2 * ss, y2 = x2 * cc + x1 * ss;
                        typedef unsigned u32x2t __attribute__((ext_vector_type(2)));
                        u32x2t w1, w2; w1.x = cvtpk(y1[0], y1[1]); w1.y = cvtpk(y1[2], y1[3]); w2.x = cvtpk(y2[0], y2[1]); w2.y = cvtpk(y2[2], y2[3]);
                        *(u32x2t*)(zt + zo + c1 + 4 * n) = w1; *(u32x2t*)(zt + zo + c2 + 4 * n) = w2;
                        asm volatile("" ::: "memory");
                    }
                    asm volatile("" ::: "memory");
                }
        } else {
            float mx0 = 0.f, mx1 = 0.f;
#pragma unroll
            for (int ai = 0; ai < 2; ++ai)
#pragma unroll
                for (int m = 0; m < 4; ++m) {
                    const unsigned zo = (unsigned)((ai * 128 + m * 16 + rloc) * 6144 + 32 * wc + 8 * fq);
#pragma unroll
                    for (int bj = 0; bj < 2; ++bj) {
                        const f32x4 v0 = acc[ai][bj][m][0], v1 = acc[ai][bj][m][1];
                        u32x4 w; w.x = cvtpk(v0[0], v0[1]); w.y = cvtpk(v0[2], v0[3]); w.z = cvtpk(v1[0], v1[1]); w.w = cvtpk(v1[2], v1[3]);
                        *(u32x4*)(zt + zo + 128 * bj) = w;
                        if (region == 1) {
                            const float a = fmaxf(fmaxf(fmaxf(fabsf(v0[0]), fabsf(v0[1])), fmaxf(fabsf(v0[2]), fabsf(v0[3]))), fmaxf(fmaxf(fabsf(v1[0]), fabsf(v1[1])), fmaxf(fabsf(v1[2]), fabsf(v1[3]))));
                            if (bj == 0) mx0 = fmaxf(mx0, a); else mx1 = fmaxf(mx1, a);
                        }
                    }
                    asm volatile("" ::: "memory");
                }
            if (region == 1) {
#pragma unroll
                for (int o = 1; o < 64; o <<= 1) { mx0 = fmaxf(mx0, __shfl_xor(mx0, o)); mx1 = fmaxf(mx1, __shfl_xor(mx1, o)); }
                if (fr == 0 && fq == 0) { unsigned* kp = kinf + (u.pm >> 3) * 4 + (u.pn & 1) * 2; atomicMax(kp, __float_as_uint(mx0)); atomicMax(kp + 1, __float_as_uint(mx1)); }
            }
        }
    }
};
struct EpiRes {
    static constexpr bool PERM = false, AFTER_DRAIN = false, INIT_ACC = true;
    float* x;
    __device__ __forceinline__ void init(f32x4 (&acc)[2][2][4][2], const Unit& u, int wr, int wc, int fr, int fq) const {
#pragma unroll
        for (int ai = 0; ai < 2; ++ai)
#pragma unroll
            for (int m = 0; m < 4; ++m) {
                const float* xr = x + (size_t)(u.pm * 256 + ai * 128 + wr * 64 + m * 16 + fr) * 2048 + u.pn * 256 + wc * 32 + 4 * fq;
#pragma unroll
                for (int bj = 0; bj < 2; ++bj)
#pragma unroll
                    for (int n = 0; n < 2; ++n) acc[ai][bj][m][n] = *(const f32x4*)(xr + bj * 128 + n * 16);
            }
    }
    __device__ __forceinline__ void store_only(const f32x4 (&acc)[2][2][4][2], const Unit& u, int wr, int wc, int fr, int fq) const {
#pragma unroll
        for (int ai = 0; ai < 2; ++ai)
#pragma unroll
            for (int m = 0; m < 4; ++m) {
                float* xr = x + (size_t)(u.pm * 256 + ai * 128 + wr * 64 + m * 16 + fr) * 2048 + u.pn * 256 + wc * 32 + 4 * fq;
#pragma unroll
                for (int bj = 0; bj < 2; ++bj)
#pragma unroll
                    for (int n = 0; n < 2; ++n) *(f32x4*)(xr + bj * 128 + n * 16) = acc[ai][bj][m][n];
            }
    }
    __device__ __forceinline__ void operator()(const f32x4 (&acc)[2][2][4][2], const Unit& u, int wr, int wc, int fr, int fq) const {
#pragma unroll
        for (int ai = 0; ai < 2; ++ai)
#pragma unroll
            for (int m = 0; m < 4; ++m) {
                const int row = u.pm * 256 + ai * 128 + wr * 64 + m * 16 + fr;
                float* xr = x + (size_t)row * 2048 + u.pn * 256 + wc * 32 + 4 * fq;
#pragma unroll
                for (int bj = 0; bj < 2; ++bj)
#pragma unroll
                    for (int n = 0; n < 2; ++n) { f32x4* p = (f32x4*)(xr + bj * 128 + n * 16); *p = *p + acc[ai][bj][m][n]; }
                asm volatile("" ::: "memory");
            }
    }
};
struct EpiSwi {
    static constexpr bool PERM = true, AFTER_DRAIN = false, INIT_ACC = false;
    bf16_t* act;
    __device__ __forceinline__ void operator()(const f32x4 (&acc)[2][2][4][2], const Unit& u, int wr, int wc, int fr, int fq) const {
#pragma unroll
        for (int ai = 0; ai < 2; ++ai)
#pragma unroll
            for (int m = 0; m < 4; ++m) {
                const int row = u.pm * 256 + ai * 128 + wr * 64 + m * 16 + fr;
                float a[8];
#pragma unroll
                for (int n = 0; n < 2; ++n)
#pragma unroll
                    for (int e = 0; e < 4; ++e) { const float g = acc[ai][0][m][n][e], up = acc[ai][1][m][n][e];
                        a[4 * n + e] = g * __builtin_amdgcn_rcpf(1.0f + __expf(-g)) * up; }
                u32x4 w; w.x = cvtpk(a[0], a[1]); w.y = cvtpk(a[2], a[3]); w.z = cvtpk(a[4], a[5]); w.w = cvtpk(a[6], a[7]);
                *(u32x4*)(act + (size_t)row * 5632 + 128 * u.pn + 32 * wc + 8 * fq) = w;
                asm volatile("" ::: "memory");
            }
    }
};

struct EpiResN {
    static constexpr bool PERM = false, AFTER_DRAIN = false, INIT_ACC = true;
    const float* xin; float* x; bf16_t* xg; const float* g; float* ssq;
    __device__ __forceinline__ void init(f32x4 (&acc)[2][2][4][2], const Unit& u, int wr, int wc, int fr, int fq) const {
#pragma unroll
        for (int ai = 0; ai < 2; ++ai)
#pragma unroll
            for (int m = 0; m < 4; ++m) {
                const float* xr = xin + (size_t)(u.pm * 256 + ai * 128 + wr * 64 + m * 16 + fr) * 2048 + u.pn * 256 + wc * 32 + 4 * fq;
#pragma unroll
                for (int bj = 0; bj < 2; ++bj)
#pragma unroll
                    for (int n = 0; n < 2; ++n) acc[ai][bj][m][n] = *(const f32x4*)(xr + bj * 128 + n * 16);
            }
    }
    __device__ __forceinline__ void store_only(const f32x4 (&acc)[2][2][4][2], const Unit& u, int wr, int wc, int fr, int fq) const {
        const int col0 = u.pn * 256 + wc * 32 + 4 * fq;
        f32x4 gv[2][2];
#pragma unroll
        for (int bj = 0; bj < 2; ++bj)
#pragma unroll
            for (int n = 0; n < 2; ++n) gv[bj][n] = *(const f32x4*)(g + col0 + bj * 128 + n * 16);
#pragma unroll
        for (int ai = 0; ai < 2; ++ai)
#pragma unroll
            for (int m = 0; m < 4; ++m) {
                const int row = u.pm * 256 + ai * 128 + wr * 64 + m * 16 + fr;
                float* xr = x + (size_t)row * 2048 + col0; bf16_t* hr = xg + (size_t)row * 2048 + col0;
                float ss = 0.f;
#pragma unroll
                for (int bj = 0; bj < 2; ++bj)
#pragma unroll
                    for (int n = 0; n < 2; ++n) {
                        const f32x4 v = acc[ai][bj][m][n]; *(f32x4*)(xr + bj * 128 + n * 16) = v;
                        const f32x4 gg = gv[bj][n];
                        ss += (v[0] * v[0] + v[1] * v[1]) + (v[2] * v[2] + v[3] * v[3]);
                        const f32x4 y = v * gg;
                        typedef unsigned u32x2t __attribute__((ext_vector_type(2)));
                        u32x2t w; w.x = cvtpk(y[0], y[1]); w.y = cvtpk(y[2], y[3]);
                        *(u32x2t*)(hr + bj * 128 + n * 16) = w;
                    }
                ss += __shfl_xor(ss, 16); ss += __shfl_xor(ss, 32);
                if (fq == 0) ssq[(size_t)row * 32 + u.pn * 4 + wc] = ss;
                asm volatile("" ::: "memory");
            }
    }
    __device__ __forceinline__ void operator()(const f32x4 (&acc)[2][2][4][2], const Unit& u, int wr, int wc, int fr, int fq) const {
        const int col0 = u.pn * 256 + wc * 32 + 4 * fq;
#pragma unroll
        for (int ai = 0; ai < 2; ++ai)
#pragma unroll
            for (int m = 0; m < 4; ++m) {
                const int row = u.pm * 256 + ai * 128 + wr * 64 + m * 16 + fr;
                float* xr = x + (size_t)row * 2048 + col0; bf16_t* hr = xg + (size_t)row * 2048 + col0;
                float ss = 0.f;
#pragma unroll
                for (int bj = 0; bj < 2; ++bj)
#pragma unroll
                    for (int n = 0; n < 2; ++n) {
                        f32x4* p = (f32x4*)(xr + bj * 128 + n * 16); const f32x4 v = *(const f32x4*)(xin + (size_t)row * 2048 + col0 + bj * 128 + n * 16) + acc[ai][bj][m][n]; *p = v;
                        const f32x4 gg = *(const f32x4*)(g + col0 + bj * 128 + n * 16);
                        ss += (v[0] * v[0] + v[1] * v[1]) + (v[2] * v[2] + v[3] * v[3]);
                        const f32x4 y = v * gg;
                        typedef unsigned u32x2t __attribute__((ext_vector_type(2)));
                        u32x2t w; w.x = cvtpk(y[0], y[1]); w.y = cvtpk(y[2], y[3]);
                        *(u32x2t*)(hr + bj * 128 + n * 16) = w;
                    }
                ss += __shfl_xor(ss, 16); ss += __shfl_xor(ss, 32);
                if (fq == 0) ssq[(size_t)row * 32 + u.pn * 4 + wc] = ss;
                asm volatile("" ::: "memory");
            }
    }
};
struct EpiSwiR {
    static constexpr bool PERM = true, AFTER_DRAIN = false, INIT_ACC = false;
    bf16_t* act; const float* rstd;
    __device__ __forceinline__ void operator()(const f32x4 (&acc)[2][2][4][2], const Unit& u, int wr, int wc, int fr, int fq) const {
        const float* rp = rstd + u.pm * 256 + wr * 64 + fr;
        float rsv[8];
#pragma unroll
        for (int g = 0; g < 8; ++g) rsv[g] = rp[(g >> 2) * 128 + (g & 3) * 16];
#pragma unroll
        for (int ai = 0; ai < 2; ++ai)
#pragma unroll
            for (int m = 0; m < 4; ++m) {
                const int row = u.pm * 256 + ai * 128 + wr * 64 + m * 16 + fr;
                const float rs = rsv[ai * 4 + m];
                float a[8];
#pragma unroll
                for (int n = 0; n < 2; ++n)
#pragma unroll
                    for (int e = 0; e < 4; ++e) { const float g = acc[ai][0][m][n][e] * rs, up = acc[ai][1][m][n][e] * rs;
                        a[4 * n + e] = g * __builtin_amdgcn_rcpf(1.0f + __expf(-g)) * up; }
                u32x4 w; w.x = cvtpk(a[0], a[1]); w.y = cvtpk(a[2], a[3]); w.z = cvtpk(a[4], a[5]); w.w = cvtpk(a[6], a[7]);
                *(u32x4*)(act + (size_t)row * 5632 + 128 * u.pn + 32 * wc + 8 * fq) = w;
                asm volatile("" ::: "memory");
            }
    }
};

template <class Epi, class Sched, bool ALIGN_EPI = false, bool SP2 = false>
__device__ __forceinline__ void gemm_phase(PG8_LAS unsigned char* lds, const Gemm g, const Sched& S, const Epi& E) {
    const int tid = tid_opaque(), wid = __builtin_amdgcn_readfirstlane(tid >> 6), lane = tid & 63, wr = wid >> 2, wc = wid & 3, fr = lane & 15, fq = lane >> 4;
    const int K = g.K, nt = K / BK;
    unsigned voffA[2], voffB[2];
#pragma unroll
    for (int i = 0; i < 2; ++i) { int R, C; stage_rc(tid * 16 + i * 8192, R, C); const int Rb = Epi::PERM ? ((R & ~31) + perm32(R & 31)) : R;
        voffA[i] = (unsigned)(R * K + C) * 2u; voffB[i] = (unsigned)(Rb * K + C) * 2u; }
    const size_t kstep = (size_t)(BK * 2);
    const size_t hstep = (size_t)HALF * K * 2;
    const size_t tstep = 2 * hstep;
    const unsigned ldsw = (unsigned)wid * 1024u;
    const int aoff = lds_byte(wr * 64 + fr, fq * 8), boff = lds_byte(wc * 32 + fr, fq * 8);
#define PG8_SA(b, h) (((b) * 2 + (h)) * HTB)
#define PG8_SB(b, h) ((4 + (b) * 2 + (h)) * HTB)
#define PG8_STAGE(bufoff, gbase, voff) do { _Pragma("unroll") for (int _i = 0; _i < 2; ++_i) \
        __builtin_amdgcn_global_load_lds((const unsigned*)((const char*)(gbase) + (voff)[_i]), (PG8_LAS unsigned*)(lds + (bufoff) + ldsw + _i * 8192), 16, 0, 0); } while (0)
#define PG8_LDA(dst, b, h) do { _Pragma("unroll") for (int m = 0; m < 4; ++m) _Pragma("unroll") for (int k = 0; k < 2; ++k) dst[m][k] = *(const PG8_LAS bf16x8*)(lds + PG8_SA(b, h) + aoff + m * 2048 + k * 1024); } while (0)
#define PG8_LDB(dst, b, h) do { _Pragma("unroll") for (int n = 0; n < 2; ++n) _Pragma("unroll") for (int k = 0; k < 2; ++k) dst[n][k] = *(const PG8_LAS bf16x8*)(lds + PG8_SB(b, h) + boff + n * 2048 + k * 1024); } while (0)
#define PG8_MMA(ai, bj, At, Bt) do { __builtin_amdgcn_s_setprio(1); _Pragma("unroll") for (int m = 0; m < 4; ++m) _Pragma("unroll") for (int n = 0; n < 2; ++n) _Pragma("unroll") for (int k = 0; k < 2; ++k) \
        acc[ai][bj][m][n] = __builtin_amdgcn_mfma_f32_16x16x32_bf16(Bt[n][k], At[m][k], acc[ai][bj][m][n], 0, 0, 0); __builtin_amdgcn_s_setprio(0); } while (0)
#define PG8_WAIT_V(n) asm volatile("s_waitcnt vmcnt(" #n ")" ::: "memory")
#define PG8_WAIT_L(n) asm volatile("s_waitcnt lgkmcnt(" #n ")" ::: "memory")
#define PG8_BAR __builtin_amdgcn_s_barrier()
#define PG8_SCHED __builtin_amdgcn_sched_barrier(0)
    Unit cur, nxt; int ui = 0;
    if (!S.next(0, cur)) return;
    f32x4 acc[2][2][4][2];
#pragma unroll
    for (int a = 0; a < 2; ++a)
#pragma unroll
        for (int b = 0; b < 2; ++b)
#pragma unroll
            for (int m = 0; m < 4; ++m)
#pragma unroll
                for (int n = 0; n < 2; ++n) acc[a][b][m][n] = (f32x4){0.f, 0.f, 0.f, 0.f};
    if constexpr (Epi::INIT_ACC) E.init(acc, cur, wr, wc, fr, fq);
    bf16x8 At[4][2], B0[2][2], B1[2][2];
    const char* cA = (const char*)g.A + (size_t)cur.pm * tstep; const char* cB = (const char*)g.Bt + (size_t)cur.pn * tstep;
    S.a_ready(cur);
    if constexpr (SP2) {
        PG8_STAGE(PG8_SB(0, 0), cB, voffB); PG8_STAGE(PG8_SB(0, 1), cB + hstep, voffB); PG8_STAGE(PG8_SA(0, 0), cA, voffA); PG8_STAGE(PG8_SA(0, 1), cA + hstep, voffA);
        if (wr == 1) PG8_BAR;
        PG8_WAIT_V(2); PG8_BAR;
        PG8_STAGE(PG8_SB(1, 0), cB + kstep, voffB); PG8_STAGE(PG8_SA(1, 0), cA + kstep, voffA); PG8_STAGE(PG8_SB(1, 1), cB + hstep + kstep, voffB);
        PG8_WAIT_V(6); PG8_BAR;
    } else {
        PG8_STAGE(PG8_SB(0, 0), cB, voffB); PG8_STAGE(PG8_SA(0, 0), cA, voffA); PG8_STAGE(PG8_SB(0, 1), cB + hstep, voffB); PG8_STAGE(PG8_SA(0, 1), cA + hstep, voffA);
        if (wr == 1) PG8_BAR;
        PG8_WAIT_V(4); PG8_BAR;
        PG8_STAGE(PG8_SB(1, 0), cB + kstep, voffB); PG8_STAGE(PG8_SA(1, 0), cA + kstep, voffA); PG8_STAGE(PG8_SB(1, 1), cB + hstep + kstep, voffB);
        PG8_WAIT_V(6); PG8_BAR;
    }
    for (;;) {
        const bool has_next = S.next(ui + 1, nxt);
        const char* nA = has_next ? (const char*)g.A + (size_t)nxt.pm * tstep : cA; const char* nB = has_next ? (const char*)g.Bt + (size_t)nxt.pn * tstep : cB;
        for (int t = 0; t < nt; t += 2) {
            const bool last = (t == nt - 2);
            const char* a1 = cA + (size_t)(t + 1) * kstep;
            const char* a2 = last ? nA : cA + (size_t)(t + 2) * kstep; const char* b2 = last ? nB : cB + (size_t)(t + 2) * kstep;
            const char* a3 = a2 + kstep; const char* b3 = b2 + kstep;
            if (last && has_next) S.a_ready(nxt);
            if constexpr (SP2) {
            PG8_LDB(B0, 0, 0); PG8_LDB(B1, 0, 1); PG8_SCHED; PG8_LDA(At, 0, 0); PG8_STAGE(PG8_SA(1, 1), a1 + hstep, voffA);
            PG8_WAIT_V(8); PG8_WAIT_L(0); PG8_BAR; PG8_MMA(0, 0, At, B0); PG8_MMA(0, 1, At, B1); PG8_BAR; PG8_SCHED;
            PG8_LDA(At, 0, 1); PG8_STAGE(PG8_SB(0, 0), b2, voffB); PG8_STAGE(PG8_SB(0, 1), b2 + hstep, voffB); PG8_STAGE(PG8_SA(0, 0), a2, voffA);
            PG8_WAIT_V(8); PG8_WAIT_L(0); PG8_BAR; PG8_MMA(1, 0, At, B0); PG8_MMA(1, 1, At, B1); PG8_BAR; PG8_SCHED;
            PG8_LDB(B0, 1, 0); PG8_LDB(B1, 1, 1); PG8_SCHED; PG8_LDA(At, 1, 0); PG8_STAGE(PG8_SA(0, 1), a2 + hstep, voffA);
            PG8_WAIT_V(8); PG8_WAIT_L(0); PG8_BAR; PG8_MMA(0, 0, At, B0); PG8_MMA(0, 1, At, B1); PG8_BAR; PG8_SCHED;
            PG8_LDA(At, 1, 1); PG8_STAGE(PG8_SB(1, 0), b3, voffB); PG8_STAGE(PG8_SB(1, 1), b3 + hstep, voffB); PG8_STAGE(PG8_SA(1, 0), a3, voffA);
            PG8_WAIT_V(8); PG8_WAIT_L(0); PG8_BAR; PG8_MMA(1, 0, At, B0); PG8_MMA(1, 1, At, B1); PG8_BAR; PG8_SCHED;
            } else {
            PG8_LDB(B0, 0, 0); PG8_SCHED; PG8_LDA(At, 0, 0); PG8_STAGE(PG8_SA(1, 1), a1 + hstep, voffA);
            PG8_WAIT_L(8); PG8_BAR; PG8_WAIT_L(0); PG8_MMA(0, 0, At, B0); PG8_BAR; PG8_SCHED;
            PG8_LDB(B1, 0, 1); PG8_STAGE(PG8_SB(0, 0), b2, voffB);
            PG8_BAR; PG8_WAIT_L(0); PG8_MMA(0, 1, At, B1); PG8_BAR;
            PG8_LDA(At, 0, 1); PG8_STAGE(PG8_SA(0, 0), a2, voffA);
            PG8_BAR; PG8_WAIT_L(0); PG8_MMA(1, 0, At, B0); PG8_BAR; PG8_SCHED;
            PG8_STAGE(PG8_SB(0, 1), b2 + hstep, voffB);
            PG8_WAIT_V(6); PG8_BAR; PG8_MMA(1, 1, At, B1); PG8_BAR;
            PG8_LDB(B0, 1, 0); PG8_SCHED; PG8_LDA(At, 1, 0); PG8_STAGE(PG8_SA(0, 1), a2 + hstep, voffA);
            PG8_WAIT_L(8); PG8_BAR; PG8_WAIT_L(0); PG8_MMA(0, 0, At, B0); PG8_BAR; PG8_SCHED;
            PG8_LDB(B1, 1, 1); PG8_STAGE(PG8_SB(1, 0), b3, voffB);
            PG8_BAR; PG8_WAIT_L(0); PG8_MMA(0, 1, At, B1); PG8_BAR;
            PG8_LDA(At, 1, 1); PG8_STAGE(PG8_SA(1, 0), a3, voffA);
            PG8_BAR; PG8_WAIT_L(0); PG8_MMA(1, 0, At, B0); PG8_BAR; PG8_SCHED;
            PG8_STAGE(PG8_SB(1, 1), b3 + hstep, voffB);
            PG8_WAIT_V(6); PG8_BAR; PG8_MMA(1, 1, At, B1); PG8_BAR;
            }
        }
        if constexpr (ALIGN_EPI) { if (wr == 0) PG8_BAR; }
        if constexpr (!Epi::AFTER_DRAIN) { if constexpr (Epi::INIT_ACC) { if (ui == 0) E.store_only(acc, cur, wr, wc, fr, fq); else E(acc, cur, wr, wc, fr, fq); } else { E(acc, cur, wr, wc, fr, fq); } S.done(cur); }
        if (!has_next) break;
#pragma unroll
        for (int a = 0; a < 2; ++a)
#pragma unroll
            for (int b = 0; b < 2; ++b)
#pragma unroll
                for (int m = 0; m < 4; ++m)
#pragma unroll
                    for (int n = 0; n < 2; ++n) acc[a][b][m][n] = (f32x4){0.f, 0.f, 0.f, 0.f};
        cur = nxt; cA = nA; cB = nB; ++ui;
        if constexpr (ALIGN_EPI) { if (wr == 1) PG8_BAR; }
    }
    PG8_WAIT_V(0);
    if constexpr (!ALIGN_EPI) { if (wr == 0) PG8_BAR; }
    PG8_BAR;
    if constexpr (Epi::AFTER_DRAIN) { E.fused(acc, cur, wr, wc, fr, fq, lds, wid, lane); S.done(cur); }
#undef PG8_SA
#undef PG8_SB
#undef PG8_STAGE
#undef PG8_LDA
#undef PG8_LDB
#undef PG8_MMA
#undef PG8_WAIT_V
#undef PG8_WAIT_L
#undef PG8_BAR
#undef PG8_SCHED
}
}
namespace att {
using pg8::bf16_t; using pg8::bf16x8; using pg8::cvtpk; using pg8::f2bf;
typedef float f32x16 __attribute__((ext_vector_type(16)));
typedef unsigned u32x4 __attribute__((ext_vector_type(4)));
constexpr int KROWB = 272, VROWB = 320, KBUF = 64 * KROWB, VBUF = 64 * VROWB;
constexpr int L_K = 0, L_V = 2 * KBUF, L_C = L_V + 2 * VBUF, L_KM = L_C + 8192, L_FLAG = L_KM + 4096, L_UNIT = L_FLAG + 64, L_WS = L_UNIT + 64, L_END = L_WS + 8 * 128;
constexpr float NEG = -1.0e30f, LOG2E = 1.4426950408889634f, LN2 = 0.6931471805599453f;
DI int crow(int i, int h) { return (i & 3) + 8 * (i >> 2) + 4 * h; }
#define MFMA32(a, b, c) __builtin_amdgcn_mfma_f32_32x32x16_bf16((a), (b), (c), 0, 0, 0)
DI bf16x8 pack8(const f32x16& x, int base) {
    u32x4 p; p.x = cvtpk(x[base], x[base + 1]); p.y = cvtpk(x[base + 2], x[base + 3]); p.z = cvtpk(x[base + 4], x[base + 5]); p.w = cvtpk(x[base + 6], x[base + 7]);
    return __builtin_bit_cast(bf16x8, p);
}
DI float bf2f(short v) { return __uint_as_float(((unsigned)(unsigned short)v) << 16); }
DI float ex2(float v) { return __builtin_amdgcn_exp2f(v); }
DI float xh_max(float v) { auto rr = __builtin_amdgcn_permlane32_swap(__float_as_uint(v), __float_as_uint(v), false, false); return fmaxf(__uint_as_float(rr[0]), __uint_as_float(rr[1])); }
DI float xh_sum(float v) { auto rr = __builtin_amdgcn_permlane32_swap(__float_as_uint(v), __float_as_uint(v), false, false); return __uint_as_float(rr[0]) + __uint_as_float(rr[1]); }
typedef short s16x4v __attribute__((ext_vector_type(4)));
DI bf16x8 vtr8(const unsigned char* p) {
    typedef __attribute__((address_space(3))) s16x4v* lp;
    const s16x4v lo = __builtin_amdgcn_ds_read_tr16_b64_v4i16((lp)(p)), hi = __builtin_amdgcn_ds_read_tr16_b64_v4i16((lp)(p + 4 * VROWB));
    return __builtin_shufflevector(lo, hi, 0, 1, 2, 3, 4, 5, 6, 7);
}
struct AttnP { const bf16_t* z; const bf16_t* vT; bf16_t* mixed; float* dA; float* dB; const float* cfox; const unsigned* kmax2; const float* gsub;
               const float* lq1; const float* lk1; const float* lq2; const float* lk2; float lam_init; };

typedef float f32x4a __attribute__((ext_vector_type(4)));
DI void scale_rows(f32x16 (&o)[4], float per_q, unsigned char* lds, int wid, int r, int h) {
    float* wsc = (float*)(lds + L_WS) + wid * 32;
    if (h == 0) wsc[r] = per_q;
#pragma unroll
    for (int g = 0; g < 4; ++g) { const f32x4a a = *(const f32x4a*)(wsc + 8 * g + 4 * h);
#pragma unroll
        for (int d = 0; d < 4; ++d) { o[d][4 * g] *= a[0]; o[d][4 * g + 1] *= a[1]; o[d][4 * g + 2] *= a[2]; o[d][4 * g + 3] *= a[3]; } }
}
template <int MODE, int KS0, int NKS>
DI void attn_pass(unsigned char* lds, const AttnP& P, int mixer, int b, int hd, int qb, int q0, int NT, int wrow, f32x16 (&o)[4], float& l_tot, unsigned sel, float scale2) {
    const int tid = tid_opaque(), lane = tid & 63, r = lane & 31, h = lane >> 5;
    const int wid = __builtin_amdgcn_readfirstlane(tid >> 6);
    const int qw0 = q0 + 32 * wrow, myq = qw0 + r, rowbase = b * SEQ;
    const bf16_t* qptr = P.z + (size_t)(rowbase + myq) * ZC + mixer * 1536 + hd * 128;
    bf16x8 qf[NKS];
#pragma unroll
    for (int s = 0; s < NKS; ++s) qf[s] = *(const bf16x8*)(qptr + 16 * (KS0 + s) + 8 * h);
    const bf16_t* kbase = P.z + (size_t)rowbase * ZC + mixer * 1536 + 512 + hd * 128;
    const bf16_t* vbase = P.z + (size_t)rowbase * ZC + mixer * 1536 + 1024 + hd * 128;
    const int kap = (r & 19) | ((r & 4) << 1) | ((r & 8) >> 1);
#pragma unroll
    for (int d = 0; d < 4; ++d)
#pragma unroll
        for (int i = 0; i < 16; ++i) o[d][i] = 0.f;
    float m_run = NEG, l_run = 0.f, carry = 0.f;
    float cq2 = 0.f;
    if (MODE == 0) cq2 = ((const float*)(lds + L_C))[myq];
    float smaxl = 0.f;
    if (MODE == 0) {
        float q2 = 0.f;
#pragma unroll
        for (int s = 0; s < NKS; ++s)
#pragma unroll
            for (int j = 0; j < 8; ++j) q2 += fabsf(bf2f(qf[s][j]));
        q2 = xh_sum(q2);
        smaxl = q2 * __uint_as_float(sel) * scale2 * 1.01f + 0.01f;
    }
    bf16x8 tf0, tf1, ones;
    if (MODE == 3) {
#pragma unroll
        for (int j = 0; j < 8; ++j) { tf0[j] = ((8 * h + j) > kap) ? (short)0x3F80 : (short)0; tf1[j] = ((16 + 8 * h + j) > kap) ? (short)0x3F80 : (short)0; ones[j] = (short)0x3F80; }
    }
    const int kr_row = tid >> 4, kr_col = tid & 15;
    struct TileRegs { u32x4 k0, k1, v0, v1; };
    TileRegs RA, RB;
#define ATT_GLOAD(t_, R_) do { const int k0_ = 64 * (t_); \
        R_.k0 = *(const u32x4*)(kbase + (size_t)(k0_ + kr_row) * ZC + kr_col * 8); R_.k1 = *(const u32x4*)(kbase + (size_t)(k0_ + kr_row + 32) * ZC + kr_col * 8); \
        R_.v0 = *(const u32x4*)(vbase + (size_t)(k0_ + kr_row) * ZC + kr_col * 8); R_.v1 = *(const u32x4*)(vbase + (size_t)(k0_ + kr_row + 32) * ZC + kr_col * 8); } while (0)
#define ATT_SSTORE(buf_, R_) do { unsigned char* kb_ = lds + L_K + (buf_) * KBUF; unsigned char* vb_ = lds + L_V + (buf_) * VBUF; \
        *(u32x4*)(kb_ + kr_row * KROWB + kr_col * 16) = R_.k0; *(u32x4*)(kb_ + (kr_row + 32) * KROWB + kr_col * 16) = R_.k1; \
        *(u32x4*)(vb_ + kr_row * VROWB + kr_col * 16) = R_.v0; *(u32x4*)(vb_ + (kr_row + 32) * VROWB + kr_col * 16) = R_.v1; } while (0)
#define ATT_TILE(it_) ((MODE == 3 || MODE == 0) ? (NT - 1 - (it_)) : (it_))
    ATT_GLOAD(ATT_TILE(0), RA); ATT_SSTORE(0, RA); __syncthreads();
    constexpr bool DEEP = (MODE == 1 || MODE == 2);
    constexpr int PF = DEEP ? 2 : 1;
    if (DEEP && NT > 1) ATT_GLOAD(ATT_TILE(1), RA);
    bool wdone = false;
    auto att_iter = [&](const int it, TileRegs& LD_, TileRegs& ST_) -> bool {
        const int cur = it & 1, t = ATT_TILE(it), key0 = 64 * t;
        const int lim = myq - key0 - 8 * h; const float limf = (float)lim;
        if (it + PF < NT) ATT_GLOAD(ATT_TILE(it + PF), LD_);
        bool active;
        if (MODE == 3) active = (key0 < qw0 + 31) && !wdone; else if (MODE == 0) active = (key0 <= qw0 + 31) && !wdone; else active = (key0 <= qw0 + 31);
        bool past = false;
        if (MODE == 1) { past = (t >> 2) < qb; if (past) active = __any((int)((sel >> (t >> 2)) & 1u)) != 0; }
        if (active) {
            const unsigned char* Kb = lds + L_K + cur * KBUF; const unsigned char* Vb = lds + L_V + cur * VBUF;
            f32x16 s0, s1;
#pragma unroll
            for (int i = 0; i < 16; ++i) { s0[i] = 0.f; s1[i] = 0.f; }
            __builtin_amdgcn_s_setprio(1);
#pragma unroll
            for (int s = 0; s < NKS; ++s) {
                const bf16x8 ka0 = *(const bf16x8*)(Kb + kap * KROWB + (16 * (KS0 + s) + 8 * h) * 2);
                const bf16x8 ka1 = *(const bf16x8*)(Kb + (32 + kap) * KROWB + (16 * (KS0 + s) + 8 * h) * 2);
                s0 = MFMA32(ka0, qf[s], s0); s1 = MFMA32(ka1, qf[s], s1);
            }
            __builtin_amdgcn_s_setprio(0);
            bf16x8 pa0, pa1, pa2, pa3;
            if (MODE != 3) {
                if (MODE == 0) {
                    const float* cl = (const float*)(lds + L_C) + key0 + 8 * h;
#pragma unroll
                    for (int i = 0; i < 16; ++i) { s0[i] = s0[i] * scale2 + (cq2 - cl[16 * (i >> 3) + (i & 7)]); s1[i] = s1[i] * scale2 + (cq2 - cl[32 + 16 * (i >> 3) + (i & 7)]); }
                } else {
                    const float blk_bias = (MODE == 1 && past && !((sel >> (t >> 2)) & 1u)) ? NEG : 0.f;
#pragma unroll
                    for (int i = 0; i < 16; ++i) { s0[i] = fmaf(s0[i], scale2, blk_bias); s1[i] = fmaf(s1[i], scale2, blk_bias); }
                }
                if (MODE == 1 && past) {
                } else if (key0 + 63 > qw0) {
#pragma unroll
                    for (int i = 0; i < 16; ++i) {
                        const float m0 = __builtin_amdgcn_fmed3f((float)(16 * (i >> 3) + (i & 7)) - limf, 0.f, 1.f), m1 = __builtin_amdgcn_fmed3f((float)(32 + 16 * (i >> 3) + (i & 7)) - limf, 0.f, 1.f);
                        s0[i] = fmaf(m0, NEG, s0[i]); s1[i] = fmaf(m1, NEG, s1[i]); }
                }
                float mloc = s0[0];
#pragma unroll
                for (int i = 0; i < 16; ++i) { mloc = fmaxf(mloc, s0[i]); mloc = fmaxf(mloc, s1[i]); }
                mloc = xh_max(mloc);
                if (__any((int)(mloc > m_run + 8.0f))) {
                    const float m_new = fmaxf(m_run, mloc);
                    const float alpha = ex2(m_run - m_new);
                    m_run = m_new; l_run *= alpha;
                    scale_rows(o, alpha, lds, wid, r, h);
                }
                float lsum = 0.f;
#pragma unroll
                for (int i = 0; i < 16; ++i) { s0[i] = ex2(s0[i] - m_run); s1[i] = ex2(s1[i] - m_run); lsum += s0[i] + s1[i]; }
                l_run += lsum;
                pa0 = pack8(s0, 0); pa1 = pack8(s0, 8); pa2 = pack8(s1, 0); pa3 = pack8(s1, 8);
            } else {
                f32x16 lb, w;
                float lsum = 0.f;
#pragma unroll
                for (int i = 0; i < 16; ++i) {
                    const float zv = s1[i] * scale2, e = ex2(-fabsf(zv) * LOG2E), tt = __builtin_amdgcn_logf(1.0f + e) * LN2;
                    const float lbv = fminf(zv, 0.f) - tt; const bool ok = (32 + 16 * (i >> 3) + (i & 7)) < lim;
                    const float Lv = ok ? (lbv - zv) : 0.f; lb[i] = ok ? lbv : NEG; s1[i] = Lv; lsum += Lv; }
                const bf16x8 x1a = pack8(s1, 0), x1b = pack8(s1, 8);
#pragma unroll
                for (int i = 0; i < 16; ++i) w[i] = 0.f;
                w = MFMA32(tf0, x1a, w); w = MFMA32(tf1, x1b, w);
#pragma unroll
                for (int i = 0; i < 16; ++i) s1[i] = ex2((lb[i] + carry + w[i]) * LOG2E);
#pragma unroll
                for (int i = 0; i < 16; ++i) {
                    const float zv = s0[i] * scale2, e = ex2(-fabsf(zv) * LOG2E), tt = __builtin_amdgcn_logf(1.0f + e) * LN2;
                    const float lbv = fminf(zv, 0.f) - tt; const bool ok = (16 * (i >> 3) + (i & 7)) < lim;
                    const float Lv = ok ? (lbv - zv) : 0.f; lb[i] = ok ? lbv : NEG; s0[i] = Lv; lsum += Lv; }
                const bf16x8 x0a = pack8(s0, 0), x0b = pack8(s0, 8);
#pragma unroll
                for (int i = 0; i < 16; ++i) w[i] = 0.f;
                w = MFMA32(tf0, x0a, w); w = MFMA32(tf1, x0b, w); w = MFMA32(ones, x1a, w); w = MFMA32(ones, x1b, w);
#pragma unroll
                for (int i = 0; i < 16; ++i) s0[i] = ex2((lb[i] + carry + w[i]) * LOG2E);
                lsum = xh_sum(lsum);
                carry += lsum;
                pa0 = pack8(s0, 0); pa1 = pack8(s0, 8); pa2 = pack8(s1, 0); pa3 = pack8(s1, 8);
            }
            __builtin_amdgcn_s_setprio(1);
#pragma unroll
            for (int d = 0; d < 4; ++d) {
                const unsigned char* vp = Vb + (8 * h + ((lane & 15) >> 2)) * VROWB + (32 * d + 16 * ((lane >> 4) & 1)) * 2 + 8 * (lane & 3);
                const bf16x8 v0 = vtr8(vp), v1 = vtr8(vp + 16 * VROWB), v2 = vtr8(vp + 32 * VROWB), v3 = vtr8(vp + 48 * VROWB);
                o[d] = MFMA32(pa0, v0, o[d]); o[d] = MFMA32(pa1, v1, o[d]); o[d] = MFMA32(pa2, v2, o[d]); o[d] = MFMA32(pa3, v3, o[d]);
            }
            __builtin_amdgcn_s_setprio(0);
        }
        if (it + 1 < NT) ATT_SSTORE(cur ^ 1, ST_);
        if (MODE == 3) {
            wdone = __all((int)(carry < -110.0f)) != 0;
            if (lane == 0) ((volatile unsigned*)(lds + L_FLAG))[(it & 1) * 8 + wid] = wdone ? 1u : 0u;
        }
        if (MODE == 0) {
            const float cprev = (key0 > 0) ? ((const float*)(lds + L_C))[key0 - 1] : 0.f;
            wdone = (key0 == 0) || (__all((int)((smaxl + cq2 - cprev) - m_run < -160.0f)) != 0);
            if (lane == 0) ((volatile unsigned*)(lds + L_FLAG))[(it & 1) * 8 + wid] = wdone ? 1u : 0u;
        }
        __syncthreads();
        if (MODE == 3 || MODE == 0) {
            const volatile unsigned* fl = (const volatile unsigned*)(lds + L_FLAG) + (it & 1) * 8;
            unsigned all = 1u;
#pragma unroll
            for (int w8 = 0; w8 < 8; ++w8) all &= fl[w8];
            if (all) return true;
        }
        return false;
    };
    for (int it = 0; it < NT; it += 2) {
        if (DEEP) { if (att_iter(it, RB, RA)) break; if (it + 1 < NT) { if (att_iter(it + 1, RA, RB)) break; } }
        else { if (att_iter(it, RA, RA)) break; if (it + 1 < NT) { if (att_iter(it + 1, RA, RA)) break; } }
    }
    l_tot = xh_sum(l_run);
#undef ATT_GLOAD
#undef ATT_SSTORE
#undef ATT_TILE
}

DI void store_o(const AttnP& P, const f32x16 (&o)[4], int mixer, int b, int hd, int qb) {
    const int tid = tid_opaque(), lane = tid & 63, r = lane & 31, h = lane >> 5, wid = tid >> 6;
    bf16_t* mp = P.mixed + (size_t)(b * SEQ + qb * 256 + 32 * wid) * DM + mixer * 512 + hd * 128 + r;
#pragma unroll
    for (int d = 0; d < 4; ++d)
#pragma unroll
        for (int i = 0; i < 16; ++i) mp[(size_t)crow(i, h) * DM + 32 * d] = f2bf(o[d][i]);
}
DI void attn_unit(unsigned char* lds, const AttnP& P, int mixer, int bh, int qb) {
    const int tid = tid_opaque(), lane = tid & 63, r = lane & 31, h = lane >> 5;
    const int wid = __builtin_amdgcn_readfirstlane(tid >> 6);
    const int b = bh >> 2, hd = bh & 3;
    const float sc128 = 0.08838834764831845f;
    f32x16 o[4]; float ltot = 1.f;
    if (mixer == 0) {
        float* cl = (float*)(lds + L_C);
        for (int t = tid; t < qb * 256 + 256; t += 512) cl[t] = P.cfox[bh * SEQ + t] * LOG2E;
        __syncthreads();
        attn_pass<0, 0, 8>(lds, P, 0, b, hd, qb, qb * 256, 4 * (qb + 1), wid, o, ltot, P.kmax2[bh], sc128 * LOG2E);
        scale_rows(o, 1.0f / ltot, lds, wid, r, h);
        store_o(P, o, 0, b, hd, qb);
    } else if (mixer == 1) {
        float* km = (float*)(lds + L_KM); float* part = (float*)(lds + L_K);
        {
            const int c8 = tid & 15, rg = tid >> 4;
            for (int n = 0; n < qb; ++n) {
                float a8[8];
#pragma unroll
                for (int j = 0; j < 8; ++j) a8[j] = 0.f;
                const bf16_t* kp = P.z + (size_t)(b * SEQ + n * 256 + rg) * ZC + 1536 + 512 + hd * 128 + c8 * 8;
#pragma unroll
                for (int i = 0; i < 8; ++i) { const bf16x8 v = *(const bf16x8*)(kp + (size_t)(32 * i) * ZC);
#pragma unroll
                    for (int j = 0; j < 8; ++j) a8[j] += bf2f(v[j]); }
#pragma unroll
                for (int j = 0; j < 8; ++j) part[rg * 128 + c8 * 8 + j] = a8[j];
                __syncthreads();
                if (tid < 128) { float s = 0.f;
#pragma unroll 8
                    for (int g = 0; g < 32; ++g) s += part[g * 128 + tid];
                    km[n * 128 + tid] = s * (1.0f / 256.0f); }
                __syncthreads();
            }
        }
        unsigned sel = 0u;
        {
            const bf16_t* qptr = P.z + (size_t)(b * SEQ + qb * 256 + 32 * wid + r) * ZC + 1536 + hd * 128;
            bf16x8 qv[8];
#pragma unroll
            for (int s = 0; s < 8; ++s) qv[s] = *(const bf16x8*)(qptr + 16 * s + 8 * h);
            float gate[8];
#pragma unroll
            for (int n = 0; n < 8; ++n) {
                gate[n] = -INFINITY;
                if (n < qb) {
                    float g = 0.f;
#pragma unroll
                    for (int s = 0; s < 8; ++s) { const float* kk = km + n * 128 + 16 * s + 8 * h;
#pragma unroll
                        for (int j = 0; j < 8; ++j) g += bf2f(qv[s][j]) * kk[j]; }
                    g = xh_sum(g);
                    gate[n] = g;
                }
            }
#pragma unroll
            for (int pick = 0; pick < 3; ++pick) {
                float best = -INFINITY; int bi = -1;
#pragma unroll
                for (int n = 0; n < 8; ++n) { const bool cand = (n < qb) && !((sel >> n) & 1u) && (gate[n] > best); if (cand) { best = gate[n]; bi = n; } }
                if (bi >= 0) sel |= (1u << bi);
            }
        }
        attn_pass<1, 0, 8>(lds, P, 1, b, hd, qb, qb * 256, 4 * (qb + 1), wid, o, ltot, sel, sc128 * LOG2E);
        scale_rows(o, 1.0f / ltot, lds, wid, r, h);
        store_o(P, o, 1, b, hd, qb);
    } else if (mixer == 2 || mixer == 4) {
        const int qb128 = (mixer == 2) ? qb : 8 + qb, q0 = qb128 * 128, NTd = 2 * (qb128 + 1), wrow = wid & 3;
        float d1 = P.lq1[lane] * P.lk1[lane], d2 = P.lq2[lane] * P.lk2[lane];
#pragma unroll
        for (int of = 1; of < 64; of <<= 1) { d1 += __shfl_xor(d1, of); d2 += __shfl_xor(d2, of); }
        const float lam = expf(d1) - expf(d2) + P.lam_init;
        if (wid < 4) attn_pass<2, 0, 4>(lds, P, 2, b, hd, 0, q0, NTd, wrow, o, ltot, 0u, 0.125f * LOG2E);
        else         attn_pass<2, 4, 4>(lds, P, 2, b, hd, 0, q0, NTd, wrow, o, ltot, 0u, 0.125f * LOG2E);
        scale_rows(o, 1.0f / ltot, lds, wid, r, h);
        float* ex = (float*)lds;
        __syncthreads();
        if (wid >= 4) {
#pragma unroll
            for (int d = 0; d < 4; ++d)
#pragma unroll
                for (int i = 0; i < 16; ++i) ex[((wrow * 4 + d) * 16 + i) * 64 + lane] = o[d][i];
        }
        __syncthreads();
        if (wid < 4) {
            float ss[16];
#pragma unroll
            for (int i = 0; i < 16; ++i) ss[i] = 0.f;
#pragma unroll
            for (int d = 0; d < 4; ++d)
#pragma unroll
                for (int i = 0; i < 16; ++i) { const float v = o[d][i] - lam * ex[((wrow * 4 + d) * 16 + i) * 64 + lane]; o[d][i] = v; ss[i] += v * v; }
#pragma unroll
            for (int i = 0; i < 16; ++i) {
#pragma unroll
                for (int of = 1; of < 32; of <<= 1) ss[i] += __shfl_xor(ss[i], of);
                ss[i] = (1.0f - P.lam_init) / sqrtf(ss[i] * (1.0f / 128.0f) + 1e-5f); }
            bf16_t* mp = P.mixed + (size_t)(b * SEQ + q0 + 32 * wrow) * DM + 2 * 512 + hd * 128 + r;
#pragma unroll
            for (int d = 0; d < 4; ++d) { const float g = P.gsub[32 * d + r];
#pragma unroll
                for (int i = 0; i < 16; ++i) mp[(size_t)crow(i, h) * DM + 32 * d] = f2bf(o[d][i] * ss[i] * g); }
        }
    } else {
        attn_pass<3, 0, 8>(lds, P, 3, b, hd, qb, qb * 256, 4 * (qb + 1), wid, o, ltot, 0u, sc128);
        store_o(P, o, 3, b, hd, qb);
    }
}
#undef MFMA32
}

#define LAS __attribute__((address_space(3)))
typedef unsigned short bf16;
typedef unsigned v4u __attribute__((ext_vector_type(4)));
typedef float f32x4 __attribute__((ext_vector_type(4)));
constexpr size_t MiB = 1u << 20;
constexpr size_t WS_CTL = 0, CTL_ZERO_BYTES = 65536;
constexpr int CW_BAR = 4096, MISC_OFF = 131072;
constexpr size_t WS_WIN = 1 * MiB, WS_WOUT = 25 * MiB, WS_WGU = 33 * MiB, WS_WDN = 77 * MiB;
constexpr size_t WS_X = 100 * MiB, WS_H = 164 * MiB, WS_Z = 196 * MiB, WS_VT = 292 * MiB, WS_MIX = 324 * MiB, WS_ACT = 356 * MiB;
constexpr size_t WS_LF = 444 * MiB, WS_CF = 445 * MiB, WS_KP = 446 * MiB, WS_COSF = 447 * MiB, WS_SINF = 448 * MiB, WS_COSH = 449 * MiB, WS_SINH = 450 * MiB, WS_SSQ = 451 * MiB, WS_RSTD = 452 * MiB, WS_END = 453 * MiB;
constexpr int LDS_BYTES = 131072 + 8192;
static_assert(att::L_END <= 131072, "attention LDS map");
constexpr int NPHASE = 25;

struct Params {
    const float* x; const float* w_in; const float* b_fgate; const float* w_out; const float* lq1; const float* lk1; const float* lq2; const float* lk2;
    const float* subln; const float* attn_norm; const float* w_gate; const float* w_up; const float* w_down; const float* ffn_norm; const float* final_norm;
    float* out; unsigned char* ws;
    float lam_init[4]; float inv_full[64]; float inv_half[32];
    int ph_lo, ph_hi;
};

DI float wave_sum(float v) {
#pragma unroll
    for (int o = 1; o < 64; o <<= 1) v += __shfl_xor(v, o);
    return v;
}
DI unsigned pk2(float lo, float hi) { return pg8::cvtpk(lo, hi); }

DI void transpose_item(const float* W, int ldw, bf16* WT, int K, LAS float* scr, int k0, int lane) {
#pragma unroll
    for (int i = 0; i < 32; ++i) { const int kk = 2 * i + (lane >> 5); scr[kk * 33 + (lane & 31)] = __builtin_nontemporal_load(W + (size_t)(k0 + kk) * ldw + (lane & 31)); }
    asm volatile("s_waitcnt lgkmcnt(0)" ::: "memory");
    const int c = lane & 7;
#pragma unroll
    for (int j = 0; j < 4; ++j) { const int n = (lane >> 3) + 8 * j; const LAS float* s = scr + (8 * c) * 33 + n;
        v4u o; o.x = pk2(s[0 * 33], s[1 * 33]); o.y = pk2(s[2 * 33], s[3 * 33]); o.z = pk2(s[4 * 33], s[5 * 33]); o.w = pk2(s[6 * 33], s[7 * 33]);
        *(v4u*)(WT + (size_t)n * K + k0 + 8 * c) = o; }
    asm volatile("s_waitcnt lgkmcnt(0)" ::: "memory");
}

DI void convert_weights(const Params& p, int l, LAS unsigned char* lds, int gw, int NGW, int wave, int lane) {
    LAS float* scr = (LAS float*)(lds + wave * 16384);
    bf16* win = (bf16*)(p.ws + WS_WIN); bf16* wout = (bf16*)(p.ws + WS_WOUT); bf16* wgu = (bf16*)(p.ws + WS_WGU); bf16* wdn = (bf16*)(p.ws + WS_WDN);
    constexpr int I_IN = 32 * 192, I_OUT = 32 * 64, I_GU = 32 * 352, I_DN = 88 * 64, NIT = I_IN + I_OUT + I_GU + I_DN;
    for (int it = gw; it < NIT; it += NGW) {
        int r = it;
        if (r < I_IN) {
            const int kb = r / 192, nb = r - kb * 192, j0 = 32 * nb, region = j0 >> 9, within = j0 & 511, t256 = within >> 8, T0 = within & 255;
            const int sT = (region == 3 || region == 4) ? ((T0 & 0x3F) | ((T0 & 0x40) << 1) | ((T0 & 0x80) >> 1)) : ((region == 6 || region == 7) ? ((T0 & 0x5F) | ((T0 & 0x20) << 2) | ((T0 & 0x80) >> 2)) : T0);
            const int src = region * 512 + (region >= 3 ? 4 : 0) + t256 * 256 + sT;
            transpose_item(p.w_in + (size_t)l * DM * WIN_LD + src, WIN_LD, win + (size_t)j0 * DM, DM, scr, 64 * kb, lane); continue; }
        r -= I_IN;
        if (r < I_OUT) { const int kb = r / 64, nb = r - kb * 64, j0 = 32 * nb;
            transpose_item(p.w_out + (size_t)l * DM * DM + j0, DM, wout + (size_t)j0 * DM, DM, scr, 64 * kb, lane); continue; }
        r -= I_OUT;
        if (r < I_GU) { const int kb = r / 352, nb = r - kb * 352, j0 = 32 * nb, pn = j0 >> 8, bj = (j0 >> 7) & 1, i0 = j0 & 127;
            const float* src = (bj ? p.w_up : p.w_gate) + (size_t)l * DM * FF + 128 * pn + i0;
            transpose_item(src, FF, wgu + (size_t)j0 * DM, DM, scr, 64 * kb, lane); continue; }
        r -= I_GU;
        { const int kb = r / 64, nb = r - kb * 64, j0 = 32 * nb;
            transpose_item(p.w_down + (size_t)l * FF * DM + j0, DM, wdn + (size_t)j0 * FF, FF, scr, 64 * kb, lane); }
    }
}

DI void sincos_d(double x, double& s, double& c) {
    const double kd = rint(x * 0.63661977236758134308);
    const int k = (int)kd;
    double rr = fma(-kd, 1.57079632679489655800e+00, x); rr = fma(-kd, 6.12323399573676603587e-17, rr);
    const double r2 = rr * rr;
    const double sp = rr * (1.0 + r2 * (-1.0 / 6 + r2 * (1.0 / 120 + r2 * (-1.0 / 5040 + r2 * (1.0 / 362880 + r2 * (-1.0 / 39916800 + r2 * (1.0 / 6227020800.0 + r2 * (-1.0 / 1307674368000.0))))))));
    const double cp = 1.0 + r2 * (-0.5 + r2 * (1.0 / 24 + r2 * (-1.0 / 720 + r2 * (1.0 / 40320 + r2 * (-1.0 / 3628800 + r2 * (1.0 / 479001600.0 + r2 * (-1.0 / 87178291200.0 + r2 * (1.0 / 20922789888000.0))))))));
    const int q = k & 3;
    s = (q == 0) ? sp : (q == 1) ? cp : (q == 2) ? -sp : -cp;
    c = (q == 0) ? cp : (q == 1) ? -sp : (q == 2) ? -cp : sp;
}
DI void rope_tables(const Params& p, int gtid, int gthreads) {
    float* cF = (float*)(p.ws + WS_COSF); float* sF = (float*)(p.ws + WS_SINF); float* cH = (float*)(p.ws + WS_COSH); float* sH = (float*)(p.ws + WS_SINH);
    for (int i = gtid; i < SEQ * 96; i += gthreads) {
        const int pos = i / 96, j = i - pos * 96;
        const float inv = (j < 64) ? p.inv_full[j] : p.inv_half[j - 64];
        const float ang = (float)pos * inv;
        double s, c; sincos_d((double)ang, s, c);
        if (j < 64) { cF[pos * 64 + j] = (float)c; sF[pos * 64 + j] = (float)s; } else { cH[pos * 32 + j - 64] = (float)c; sH[pos * 32 + j - 64] = (float)s; }
    }
}

template <bool OUTF32, bool COPY, bool FG>
DI void rms_row(const float* xrow, const float* g, void* orow, float* xcopy, const LAS f32x4* wfg, f32x4& fgacc, int lane) {
    const f32x4* xr = (const f32x4*)xrow + lane;
    f32x4 v[8]; float ss = 0.f;
#pragma unroll
    for (int j = 0; j < 8; ++j) { v[j] = xr[64 * j]; ss += (v[j].x * v[j].x + v[j].y * v[j].y) + (v[j].z * v[j].z + v[j].w * v[j].w); }
    const float rstd = 1.0f / sqrtf(wave_sum(ss) * (1.0f / DM) + 1e-6f);
    f32x4 fa = {0.f, 0.f, 0.f, 0.f};
#pragma unroll
    for (int j = 0; j < 8; ++j) {
        if (COPY) ((f32x4*)xcopy)[64 * j + lane] = v[j];
        const f32x4 gg = ((const f32x4*)g)[64 * j + lane];
        const f32x4 y = v[j] * rstd * gg;
        if (OUTF32) ((f32x4*)orow)[64 * j + lane] = y;
        else { unsigned long long w = (unsigned long long)pk2(y.x, y.y) | ((unsigned long long)pk2(y.z, y.w) << 32); ((unsigned long long*)orow)[64 * j + lane] = w; }
        if (FG) { const int k = 4 * (64 * j + lane); fa += y.x * wfg[k] + y.y * wfg[k + 1] + y.z * wfg[k + 2] + y.w * wfg[k + 3]; }
    }
    fgacc = fa;
}

#define XB_TMO      128
#define XB_XCNT(j)  (256  + 64 * (j))
#define XB_XSUB(j)  (1280 + 64 * (j))
#define XB_XGEN(j)  (2304 + 64 * (j))
#define XB_TOP      3328
#define XB_TOPGEN   3392
#define XCD_BAR_WORDS 3456
#define XB_SPIN_CAP (1u << 18)

__device__ __forceinline__ unsigned xb_ld(unsigned* p)              { return __hip_atomic_load(p, __ATOMIC_RELAXED, __HIP_MEMORY_SCOPE_AGENT); }
__device__ __forceinline__ unsigned xb_add(unsigned* p, unsigned v) { return __hip_atomic_fetch_add(p, v, __ATOMIC_RELAXED, __HIP_MEMORY_SCOPE_AGENT); }
__device__ __forceinline__ unsigned xb_xcc_id() { return (unsigned)__builtin_amdgcn_s_getreg((3 << 11) | 20) & 0xFu; }
#define XB_SPIN(cond, bar) do { unsigned _sp = 0; while (cond) { __builtin_amdgcn_s_sleep(1); \
    if ((++_sp & 255u) == 0u) { if (xb_ld(&(bar)[XB_TMO])) break; if (_sp > XB_SPIN_CAP) { atomicAdd(&(bar)[XB_TMO], 1u); break; } } } } while (0)

struct XcdBarrier {
    unsigned* bar; unsigned x;
    volatile LAS unsigned* st;
};

__device__ __forceinline__ XcdBarrier xcd_barrier_post(unsigned* bar, volatile LAS unsigned* st) {
    XcdBarrier b; b.bar = bar; b.x = xb_xcc_id(); b.st = st;
    if (threadIdx.x == 0) (void)xb_add(&bar[XB_XCNT(b.x)], 1u);
    return b;
}
__device__ __forceinline__ void xcd_barrier_complete(unsigned* bar, unsigned x, unsigned& nloc, unsigned& nx) {
    const unsigned G = gridDim.x * gridDim.y * gridDim.z;
    unsigned sum, cnt, mine, sp = 0u;
    for (;;) {
        sum = 0u; cnt = 0u; mine = 0u;
#pragma unroll
        for (unsigned j = 0; j < 16; ++j) { const unsigned c = xb_ld(&bar[XB_XCNT(j)]); sum += c; cnt += (c > 0u) ? 1u : 0u; mine = (j == x) ? c : mine; }
        if (sum == G) break;
        __builtin_amdgcn_s_sleep(1);
        if ((++sp & 255u) == 0u) { if (xb_ld(&bar[XB_TMO])) break; if (sp > XB_SPIN_CAP) { atomicAdd(&bar[XB_TMO], 1u); break; } }
    }
    nloc = mine > 0u ? mine : 1u; nx = cnt > 0u ? cnt : 1u;
}

__device__ __forceinline__ void xcd_barrier(const XcdBarrier& b) {
    asm volatile("s_waitcnt vmcnt(0)" ::: "memory");
    __syncthreads();
    if (threadIdx.x == 0) {
        unsigned* bar = b.bar;
        __builtin_amdgcn_s_waitcnt(0);
        unsigned nloc = b.st[0], nx = b.st[1];
        if (nloc == 0u) { xcd_barrier_complete(bar, b.x, nloc, nx); b.st[0] = nloc; b.st[1] = nx; }
        const unsigned old = xb_add(&bar[XB_XSUB(b.x)], 1u);
        const unsigned gen = old / nloc;
        if (old + 1u == (gen + 1u) * nloc) {
            __builtin_amdgcn_fence(__ATOMIC_RELEASE, "agent");
            asm volatile("s_waitcnt vmcnt(0)" ::: "memory");
            const unsigned og = xb_add(&bar[XB_TOP], 1u);
            const unsigned tg = og / nx;
            if (og + 1u == (tg + 1u) * nx) xb_add(&bar[XB_TOPGEN], 1u);
            else XB_SPIN(xb_ld(&bar[XB_TOPGEN]) == tg, bar);
            __builtin_amdgcn_fence(__ATOMIC_ACQUIRE, "agent");
            xb_add(&bar[XB_XGEN(b.x)], 1u);
            asm volatile("s_waitcnt vmcnt(0)" ::: "memory");
        } else {
            XB_SPIN(xb_ld(&bar[XB_XGEN(b.x)]) == gen, bar);
            __builtin_amdgcn_fence(__ATOMIC_ACQUIRE, "agent");
            asm volatile("s_waitcnt vmcnt(0)" ::: "memory");
        }
    }
    __syncthreads();
}

DI void post_phase(bf16* zb, bf16* vT, unsigned char* ws, LAS unsigned char* lds, int bx, int G, int tid, unsigned* kmax2) {
    typedef short s16x8 __attribute__((ext_vector_type(8)));
    const float* cosF = (const float*)(ws + WS_COSF); const float* sinF = (const float*)(ws + WS_SINF);
    const float* cosH = (const float*)(ws + WS_COSH); const float* sinH = (const float*)(ws + WS_SINH);
    for (int task = bx * 512 + tid; task < M_TOK * 128; task += G * 512) {
        const int row = task >> 7, j = task & 127, pos = row & 2047;
        int c1, c2; unsigned to; const float* ct; const float* st;
        if (j < 64) { const int i0 = (j & 7) * 8; c1 = 1536 + (j >> 3) * 128 + i0; c2 = c1 + 64; to = (unsigned)(pos * 64 + i0); ct = cosF; st = sinF; }
        else { const int jj = j - 64, i0 = (jj & 3) * 8; c1 = 3072 + (jj >> 2) * 64 + i0; c2 = c1 + 32; to = (unsigned)(pos * 32 + i0); ct = cosH; st = sinH; }
        bf16* zr = zb + (size_t)row * ZC;
        const s16x8 a = *(const s16x8*)(zr + c1), b2 = *(const s16x8*)(zr + c2);
        const f32x4 ca = *(const f32x4*)(ct + to), cb = *(const f32x4*)(ct + to + 4), sa = *(const f32x4*)(st + to), sb = *(const f32x4*)(st + to + 4);
        float y1[8], y2[8];
#pragma unroll
        for (int e = 0; e < 8; ++e) { const float x1 = att::bf2f(a[e]), x2 = att::bf2f(b2[e]); const float c = (e < 4) ? ca[e & 3] : cb[e & 3], s = (e < 4) ? sa[e & 3] : sb[e & 3];
            y1[e] = x1 * c - x2 * s; y2[e] = x2 * c + x1 * s; }
        v4u w1, w2;
        w1.x = pk2(y1[0], y1[1]); w1.y = pk2(y1[2], y1[3]); w1.z = pk2(y1[4], y1[5]); w1.w = pk2(y1[6], y1[7]);
        w2.x = pk2(y2[0], y2[1]); w2.y = pk2(y2[2], y2[3]); w2.z = pk2(y2[4], y2[5]); w2.w = pk2(y2[6], y2[7]);
        *(v4u*)(zr + c1) = w1; *(v4u*)(zr + c2) = w2;
    }
    const int lane = tid & 63, wave = tid >> 6;
    for (int chunk = bx; chunk < M_TOK / 32; chunk += G) {
        float mx0 = 0.f, mx1 = 0.f, mx2 = 0.f, mx3 = 0.f;
#pragma unroll
        for (int i = 0; i < 4; ++i) {
            const int row = chunk * 32 + wave * 4 + i;
            const bf16* kr = zb + (size_t)row * ZC + 512 + 2 * lane;
#pragma unroll
            for (int head = 0; head < 4; ++head) {
                const unsigned w = *(const unsigned*)(kr + head * 128);
                const float a = __uint_as_float(w << 16), b2 = __uint_as_float(w & 0xffff0000u);
                const float ss = wave_sum(a * a + b2 * b2);
                if (head == 0) mx0 = fmaxf(mx0, ss); else if (head == 1) mx1 = fmaxf(mx1, ss); else if (head == 2) mx2 = fmaxf(mx2, ss); else mx3 = fmaxf(mx3, ss);
            }
        }
        volatile LAS float* red = (volatile LAS float*)(lds + 8 * 9216);
        __syncthreads();
        if (lane == 0) { red[wave * 4 + 0] = mx0; red[wave * 4 + 1] = mx1; red[wave * 4 + 2] = mx2; red[wave * 4 + 3] = mx3; }
        __syncthreads();
        if (tid < 4) { float m = 0.f;
#pragma unroll
            for (int w8 = 0; w8 < 8; ++w8) m = fmaxf(m, red[w8 * 4 + tid]);
            atomicMax(kmax2 + ((chunk * 32) >> 11) * 4 + tid, __float_as_uint(m)); }
    }
    __syncthreads();
}

__constant__ unsigned char g_unit_order[40] = {7, 15, 6, 14, 23, 39, 5, 13, 22, 38, 4, 12, 21, 37, 3, 11, 20, 36, 2, 10, 19, 35, 18, 34, 1, 9, 17, 33, 0, 8, 16, 32, 31, 30, 29, 28, 27, 26, 25, 24};
DI void diff_combine(const float* dA, const float* dB, bf16* mixed, const float* gsub, const float* lq1, const float* lk1, const float* lq2, const float* lk2, float lam_init, int gw, int NGW, int lane) {
    float d1 = lq1[lane] * lk1[lane], d2 = lq2[lane] * lk2[lane];
    d1 = wave_sum(d1); d2 = wave_sum(d2);
    const float lam = expf(d1) - expf(d2) + lam_init;
    const float g0 = gsub[2 * lane] * (1.0f - lam_init), g1 = gsub[2 * lane + 1] * (1.0f - lam_init);
    for (int t = gw; t < M_TOK * 4; t += NGW) {
        typedef float f32x2v __attribute__((ext_vector_type(2)));
        const f32x2v a = *(const f32x2v*)(dA + (size_t)t * 128 + 2 * lane), b2 = *(const f32x2v*)(dB + (size_t)t * 128 + 2 * lane);
        const float v0 = a.x - lam * b2.x, v1 = a.y - lam * b2.y;
        const float ss = wave_sum(v0 * v0 + v1 * v1);
        const float rs = 1.0f / sqrtf(ss * (1.0f / 128.0f) + 1e-5f);
        const int row = t >> 2, head = t & 3;
        *(unsigned*)(mixed + (size_t)row * DM + 1024 + head * 128 + 2 * lane) = pk2(v0 * rs * g0, v1 * rs * g1);
    }
}

__global__ void __launch_bounds__(512, 2) fwd_kernel(Params p) {
    extern __shared__ __attribute__((aligned(16))) unsigned char lds[];
    cg::grid_group grid = cg::this_grid();
    { volatile LAS unsigned* misc = (volatile LAS unsigned*)((LAS unsigned char*)lds + MISC_OFF); if (threadIdx.x < 16) misc[threadIdx.x] = 0u; }
    __syncthreads();
    XcdBarrier bar = xcd_barrier_post((unsigned*)(p.ws + WS_CTL) + CW_BAR, (volatile LAS unsigned*)((LAS unsigned char*)lds + MISC_OFF) + 8);
    if (p.ph_lo == 0) rope_tables(p, (int)(blockIdx.x * 512 + threadIdx.x), (int)(gridDim.x * 512));
    for (int ph = p.ph_lo; ph < p.ph_hi; ++ph) {
        if (ph == p.ph_lo + 1) grid.sync();
        else if (ph > p.ph_lo) xcd_barrier(bar);
        const int tid = tid_opaque(), lane = tid & 63, wave = __builtin_amdgcn_readfirstlane(tid >> 6);
        int G = gridDim.x, bx = blockIdx.x; size_t wsoff = 0;
        asm volatile("" : "+s"(G), "+s"(bx), "+s"(wsoff));
        unsigned char* ws = p.ws + wsoff;
        const int gw = bx * 8 + wave, NGW = G * 8;
        LAS unsigned char* ldsl = (LAS unsigned char*)lds;
        bf16* win = (bf16*)(ws + WS_WIN); bf16* wout = (bf16*)(ws + WS_WOUT); bf16* wgu = (bf16*)(ws + WS_WGU); bf16* wdn = (bf16*)(ws + WS_WDN);
        float* xres = (float*)(ws + WS_X); bf16* hb = (bf16*)(ws + WS_H); bf16* zb = (bf16*)(ws + WS_Z); bf16* vT = (bf16*)(ws + WS_VT);
        bf16* mixed = (bf16*)(ws + WS_MIX); bf16* act = (bf16*)(ws + WS_ACT);
        float* lf = (float*)(ws + WS_LF); float* cf = (float*)(ws + WS_CF);
        unsigned* ctl = (unsigned*)(ws + WS_CTL);
        if (ph == NPHASE - 1) {
            f32x4 dummy;
            for (int m = gw; m < M_TOK; m += NGW) rms_row<true, false, false>(xres + (size_t)m * DM, p.final_norm, p.out + (size_t)m * DM, nullptr, nullptr, dummy, lane);
            continue;
        }
        const int l = ph / 6; int k = ph - 6 * l;
        if (k >= 4) ++k;
        if (k == 0) {
            convert_weights(p, l, ldsl, gw, NGW, wave, lane);
            __syncthreads();
            LAS f32x4* wfg = (LAS f32x4*)ldsl;
            const float* wl = p.w_in + (size_t)l * DM * WIN_LD + 1536;
            for (int kk = tid; kk < DM; kk += 512) wfg[kk] = *(const f32x4*)(wl + (size_t)kk * WIN_LD);
            __syncthreads();
            const float* xs = (l == 0) ? p.x : xres;
            const f32x4 bias = *(const f32x4*)(p.b_fgate + 4 * l);
            for (int m = gw; m < M_TOK; m += NGW) {
                f32x4 fa;
                rms_row<false, false, true>(xs + (size_t)m * DM, p.attn_norm + l * DM, hb + (size_t)m * DM, nullptr, wfg, fa, lane);
                fa.x = wave_sum(fa.x); fa.y = wave_sum(fa.y); fa.z = wave_sum(fa.z); fa.w = wave_sum(fa.w);
                if (lane < 4) {
                    const float v = (lane == 0 ? fa.x + bias.x : lane == 1 ? fa.y + bias.y : lane == 2 ? fa.z + bias.z : fa.w + bias.w);
                    const float ls = fminf(v, 0.f) - log1pf(expf(-fabsf(v)));
                    const int b = m >> 11, t = m & 2047;
                    lf[(b * 4 + lane) * SEQ + t] = ls;
                }
            }
            __syncthreads();
        } else if (k == 1) {
            if (bx < 16 && wave == 0) {
                const float* src = lf + bx * SEQ + 32 * lane; float* dst = cf + bx * SEQ + 32 * lane;
                float v[32]; float run = 0.f;
#pragma unroll
                for (int i = 0; i < 32; ++i) { v[i] = src[i]; run += v[i]; }
                float tot = run;
#pragma unroll
                for (int o = 1; o < 64; o <<= 1) { const float t = __shfl_up(tot, o); if (lane >= o) tot += t; }
                float accv = tot - run;
#pragma unroll
                for (int i = 0; i < 32; ++i) { accv += v[i]; dst[i] = accv; }
            }
            pg8::Gemm g{hb, win, M_TOK, ZC, DM}; pg8::StaticOrder S; S.init(M_TOK, ZC, G, bx);
            pg8::EpiZ E{zb, (const float*)(ws + WS_COSF), (const float*)(ws + WS_SINF), (const float*)(ws + WS_COSH), (const float*)(ws + WS_SINH), ctl + 2304 + 16 * l};
            pg8::gemm_phase<pg8::EpiZ, pg8::StaticOrder, true, true>(ldsl, g, S, E);
        } else if (k == 2) {
            att::AttnP AP{zb, vT, mixed, (float*)(ws + WS_ACT), (float*)(ws + WS_ACT + 16 * MiB), cf, (const unsigned*)(ctl + 2304 + 16 * l), p.subln + l * 128, p.lq1 + l * 64, p.lk1 + l * 64, p.lq2 + l * 64, p.lk2 + l * 64, p.lam_init[l]};
            volatile unsigned* shu = (volatile unsigned*)(lds + att::L_UNIT);
            const int myx = (int)(bar.x & 7u);
            for (;;) {
                __syncthreads();
                if (tid == 0) {
                    unsigned got = 0xffffffffu;
                    for (int kq = 0; kq < 8; ++kq) { const int xq = (myx + kq) & 7; const unsigned v = atomicAdd(ctl + 64 * (l * 8 + xq), 1u); if (v < 80u) { got = (unsigned)xq * 80u + v; break; } }
                    *shu = got;
                }
                __syncthreads();
                const unsigned u = *shu;
                if (u == 0xffffffffu) break;
                const unsigned xq = u / 80u, v = u - xq * 80u;
                const int e = g_unit_order[v >> 1];
                att::attn_unit(lds, AP, e >> 3, (int)(2u * xq + (v & 1u)), e & 7);
            }
        } else if (k == 3) {
            pg8::Gemm g{mixed, wout, M_TOK, DM, DM}; pg8::StaticOrder S; S.init(M_TOK, DM, G, bx);
            pg8::EpiResN E{(l == 0) ? p.x : (const float*)xres, xres, hb, p.ffn_norm + l * DM, (float*)(ws + WS_SSQ)};
            pg8::gemm_phase<pg8::EpiResN, pg8::StaticOrder, false, true>(ldsl, g, S, E);
        } else if (k == 5) {
            pg8::Gemm g{hb, wgu, M_TOK, 2 * FF, DM}; pg8::StaticOrder S; S.init(M_TOK, 2 * FF, G, bx);
            float* rstd = (float*)(ws + WS_RSTD); const float* ssq = (const float*)(ws + WS_SSQ);
            {
                int rowj[3]; float sj[3];
#pragma unroll
                for (int j = 0; j < 3; ++j) {
                    pg8::Unit uu; const int k = tid + 512 * j;
                    const bool ok = S.next(k >> 8, uu);
                    rowj[j] = ok ? (uu.pm * 256 + (k & 255)) : -1;
                    const f32x4* sp = (const f32x4*)(ssq + (size_t)(ok ? rowj[j] : 0) * 32); float s = 0.f;
#pragma unroll
                    for (int q = 0; q < 8; ++q) { const f32x4 v = sp[q]; s += (v.x + v.y) + (v.z + v.w); }
                    sj[j] = s;
                }
#pragma unroll
                for (int j = 0; j < 3; ++j) if (rowj[j] >= 0) rstd[rowj[j]] = 1.0f / sqrtf(sj[j] * (1.0f / DM) + 1e-6f);
                asm volatile("s_waitcnt vmcnt(0)" ::: "memory");
                __syncthreads();
            }
            pg8::EpiSwiR E{act, rstd};
            pg8::gemm_phase<pg8::EpiSwiR, pg8::StaticOrder, true, true>(ldsl, g, S, E);
        } else {
            pg8::Gemm g{act, wdn, M_TOK, DM, FF}; pg8::StaticOrder S; S.init(M_TOK, DM, G, bx);
            pg8::EpiRes E{xres};
            pg8::gemm_phase<pg8::EpiRes, pg8::StaticOrder, false, true>(ldsl, g, S, E);
        }
    }
}

#ifndef MK_MULTI
#define MK_MULTI 0
#endif
extern "C" void kernel_launch(void* const* d_in, const int* in_sizes, int n_in, void* d_out, int out_size, void* d_ws, size_t ws_size, hipStream_t stream) {
    static int grid = 0;
    if (grid == 0) {
        if (n_in != 15 || in_sizes[0] != M_TOK * DM || out_size != M_TOK * DM || ws_size < WS_END) { fprintf(stderr, "kernel_launch: unexpected shapes (n_in %d, ws %zu)\n", n_in, ws_size); grid = -1; return; }
        int dev = 0, cus = 0, per_cu = 0;
        hipGetDevice(&dev); hipDeviceGetAttribute(&cus, hipDeviceAttributeMultiprocessorCount, dev);
        if (hipFuncSetAttribute((const void*)fwd_kernel, hipFuncAttributeMaxDynamicSharedMemorySize, LDS_BYTES) != hipSuccess) { fprintf(stderr, "kernel_launch: hipFuncSetAttribute failed\n"); grid = -1; return; }
        if (hipOccupancyMaxActiveBlocksPerMultiprocessor(&per_cu, (const void*)fwd_kernel, 512, LDS_BYTES) != hipSuccess || per_cu < 1) { fprintf(stderr, "kernel_launch: occupancy query says %d\n", per_cu); per_cu = 1; }
        (void)hipGetLastError();
        grid = cus * per_cu;
    }
    if (grid < 0) return;
    hipMemsetAsync((char*)d_ws + WS_CTL, 0, CTL_ZERO_BYTES, stream);
    Params p{};
    p.x = (const float*)d_in[0]; p.w_in = (const float*)d_in[1]; p.b_fgate = (const float*)d_in[2]; p.w_out = (const float*)d_in[3];
    p.lq1 = (const float*)d_in[4]; p.lk1 = (const float*)d_in[5]; p.lq2 = (const float*)d_in[6]; p.lk2 = (const float*)d_in[7];
    p.subln = (const float*)d_in[8]; p.attn_norm = (const float*)d_in[9]; p.w_gate = (const float*)d_in[10]; p.w_up = (const float*)d_in[11];
    p.w_down = (const float*)d_in[12]; p.ffn_norm = (const float*)d_in[13]; p.final_norm = (const float*)d_in[14];
    p.out = (float*)d_out; p.ws = (unsigned char*)d_ws;
    for (int l = 0; l < 4; ++l) p.lam_init[l] = (float)(0.8 - 0.6 * std::exp(-0.3 * (double)l));
    for (int i = 0; i < 64; ++i) p.inv_full[i] = (float)(1.0 / std::pow(10000.0, (double)(2 * i) / 128.0));
    for (int i = 0; i < 32; ++i) p.inv_half[i] = (float)(1.0 / std::pow(10000.0, (double)(2 * i) / 64.0));
#if MK_MULTI
    for (int ph = 0; ph < NPHASE; ++ph) { p.ph_lo = ph; p.ph_hi = ph + 1; hipLaunchKernelGGL(fwd_kernel, dim3(grid), dim3(512), LDS_BYTES, stream, p); }
#else
    p.ph_lo = 0; p.ph_hi = NPHASE;
    void* args[] = {&p};
    hipError_t e = hipLaunchCooperativeKernel((const void*)fwd_kernel, dim3(grid), dim3(512), args, LDS_BYTES, stream);
    if (e != hipSuccess) fprintf(stderr, "cooperative launch failed: %s (grid %d)\n", hipGetErrorString(e), grid);
#endif
}
```

```cpp
#include <hip/hip_runtime.h>
#include <hip/hip_cooperative_groups.h>
#include <cstdio>
#include <cstdint>
#include <cmath>
namespace cg = cooperative_groups;
#define DI __device__ __forceinline__
constexpr int M_TOK = 8192, DM = 2048, SEQ = 2048, ZC = 6144, FF = 5632, WIN_LD = 6148;
DI int tid_opaque() { int t = threadIdx.x; asm volatile("" : "+v"(t)); return t; }
namespace pg8 {
#define PG8_LAS __attribute__((address_space(3)))
typedef unsigned short bf16_t;
typedef short bf16x8 __attribute__((ext_vector_type(8)));
typedef float f32x4 __attribute__((ext_vector_type(4)));
typedef unsigned u32x4 __attribute__((ext_vector_type(4)));
constexpr int BM = 256, BK = 64, HALF = 128, HTB = HALF * BK * 2  , STAGE_BYTES = 8 * HTB, NXCD = 8, WGM = 4;

__host__ __device__ __forceinline__ int lds_byte(int r, int c) { const int st = (r >> 4) * 2 + (c >> 5), rr = r & 15, cc = c & 31, ob = rr * 64 + cc * 2; return st * 1024 + (ob ^ (((ob >> 9) & 1) << 5)); }
__host__ __device__ __forceinline__ void stage_rc(int b, int& R, int& C) { const int st = b / 1024, sb = b % 1024, swz = sb ^ (((sb >> 9) & 1) << 5); R = (st >> 1) * 16 + swz / 64; C = (st & 1) * 32 + (swz % 64) / 2; }
__host__ __device__ __forceinline__ int perm32(int rho) { const int n = rho >> 4, i = rho & 15; return 8 * (i >> 2) + 4 * n + (i & 3); }

struct Unit { int pm, pn; };
struct Gemm { const bf16_t* A; const bf16_t* Bt; int M, N, K; };

struct StaticOrder {
    int nM, nN, nwg, G, c;
    __host__ __device__ void init(int M, int N, int G_, int c_) { nM = M / BM; nN = N / BM; nwg = nM * nN; G = G_; c = c_; }
    __host__ __device__ bool next(int i, Unit& u) const {
        const long L = (long)i * G + c; if (L >= nwg) return false;
        int wgid = (int)L; { const int q = nwg / NXCD, r = nwg % NXCD, xcd = wgid % NXCD, off = wgid / NXCD; wgid = (xcd < r ? xcd * (q + 1) : r * (q + 1) + (xcd - r) * q) + off; }
        const int nig = WGM * nN, gid = wgid / nig, fm = gid * WGM, gsz = (nM - fm) < WGM ? (nM - fm) : WGM;
        u.pm = fm + ((wgid % nig) % gsz); u.pn = (wgid % nig) / gsz; return true;
    }
    __device__ __forceinline__ void a_ready(const Unit&) const {}
    __device__ __forceinline__ void done(const Unit&) const {}
};

typedef float f32x2_t __attribute__((ext_vector_type(2))); typedef __bf16 bf16x2_t __attribute__((ext_vector_type(2)));
__device__ __forceinline__ unsigned cvtpk(float lo, float hi) { f32x2_t v = {lo, hi}; bf16x2_t b = __builtin_convertvector(v, bf16x2_t); return __builtin_bit_cast(unsigned, b); }
__device__ __forceinline__ bf16_t f2bf(float f) { return (bf16_t)(cvtpk(f, 0.f) & 0xffffu); }
struct EpiZ {
    static constexpr bool PERM = true, AFTER_DRAIN = false, INIT_ACC = false;
    bf16_t* z; const float* cosF; const float* sinF; const float* cosH; const float* sinH; unsigned* kinf;
    __device__ __forceinline__ void operator()(const f32x4 (&acc)[2][2][4][2], const Unit& u, int wr, int wc, int fr, int fq) const {
        const int region = u.pn >> 1;
        asm volatile("" : "+v"(fq), "+v"(fr));
        const int rloc = wr * 64 + fr;
        bf16_t* zt = z + (size_t)(u.pm * 256) * 6144 + 256 * u.pn;
        if (region == 3 || region == 4 || region == 6 || region == 7) {
            const bool full = (region < 6);
            const int headin = full ? (wc >> 1) : (wc & 1);
            const int i0 = full ? (32 * (wc & 1) + 8 * fq) : (8 * fq);
            const int c1 = full ? (128 * headin + i0) : (128 * headin + 64 * (wc >> 1) + i0);
            const int c2 = c1 + (full ? 64 : 32);
            const int tw = full ? 64 : 32;
            const float* ct = full ? cosF : cosH; const float* st = full ? sinF : sinH;
#pragma unroll
            for (int ai = 0; ai < 2; ++ai)
#pragma unroll
                for (int m = 0; m < 4; ++m) {
                    const int rr = ai * 128 + m * 16 + rloc; const int pos = (u.pm * 256 + rr) & 2047;
                    const unsigned to = (unsigned)(pos * tw + i0);
                    const unsigned zo = (unsigned)(rr * 6144);
#pragma unroll
                    for (int n = 0; n < 2; ++n) {
                        const f32x4 cc = *(const f32x4*)(ct + to + 4 * n), ss = *(const f32x4*)(st + to + 4 * n);
                        const f32x4 x1 = acc[ai][0][m][n], x2 = acc[ai][1][m][n];
                        const f32x4 y1 = x1 * cc - x2 * ss, y2 = x2 * cc + x1 * ss;
                        typedef unsigned u32x2t __attribute__((ext_vector_type(2)));
                        u32x2t w1, w2; w1.x = cvtpk(y1[0], y1[1]); w1.y = cvtpk(y1[2], y1[3]); w2.x = cvtpk(y2[0], y2[1]); w2.y = cvtpk(y2[2], y2[3]);
                        *(u32x2t*)(zt + zo + c1 + 4 * n) = w1; *(u32x2t*)(zt + zo + c2 + 4 * n) = w2;
                        asm volatile("" ::: "memory");
                    }
                    asm volatile("" ::: "memory");
                }
        } else {
            float mx0 = 0.f, mx1 = 0.f;
#pragma unroll
            for (int ai = 0; ai < 2; ++ai)
#pragma unroll
                for (int m = 0; m < 4; ++m) {
                    const unsigned zo = (unsigned)((ai * 128 + m * 16 + rloc) * 6144 + 32 * wc + 8 * fq);
#pragma unroll
                    for (int bj = 0; bj < 2; ++bj) {
                        const f32x4 v0 = acc[ai][bj][m][0], v1 = acc[ai][bj][m][1];
                        u32x4 w; w.x = cvtpk(v0[0], v0[1]); w.y = cvtpk(v0[2], v0[3]); w.z = cvtpk(v1[0], v1[1]); w.w = cvtpk(v1[2], v1[3]);
                        *(u32x4*)(zt + zo + 128 * bj) = w;
                        if (region == 1) {
                            const float a = fmaxf(fmaxf(fmaxf(fabsf(v0[0]), fabsf(v0[1])), fmaxf(fabsf(v0[2]), fabsf(v0[3]))), fmaxf(fmaxf(fabsf(v1[0]), fabsf(v1[1])), fmaxf(fabsf(v1[2]), fabsf(v1[3]))));
                            if (bj == 0) mx0 = fmaxf(mx0, a); else mx1 = fmaxf(mx1, a);
                        }
                    }
                    asm volatile("" ::: "memory");
                }
            if (region == 1) {
#pragma unroll
                for (int o = 1; o < 64; o <<= 1) { mx0 = fmaxf(mx0, __shfl_xor(mx0, o)); mx1 = fmaxf(mx1, __shfl_xor(mx1, o)); }
                if (fr == 0 && fq == 0) { unsigned* kp = kinf + (u.pm >> 3) * 4 + (u.pn & 1) * 2; atomicMax(kp, __float_as_uint(mx0)); atomicMax(kp + 1, __float_as_uint(mx1)); }
            }
        }
    }
};
struct EpiRes {
    static constexpr bool PERM = false, AFTER_DRAIN = false, INIT_ACC = true;
    float* x;
    __device__ __forceinline__ void init(f32x4 (&acc)[2][2][4][2], const Unit& u, int wr, int wc, int fr, int fq) const {
#pragma unroll
        for (int ai = 0; ai < 2; ++ai)
#pragma unroll
            for (int m = 0; m < 4; ++m) {
                const float* xr = x + (size_t)(u.pm * 256 + ai * 128 + wr * 64 + m * 16 + fr) * 2048 + u.pn * 256 + wc * 32 + 4 * fq;
#pragma unroll
                for (int bj = 0; bj < 2; ++bj)
#pragma unroll
                    for (int n = 0; n < 2; ++n) acc[ai][bj][m][n] = *(const f32x4*)(xr + bj * 128 + n * 16);
            }
    }
    __device__ __forceinline__ void store_only(const f32x4 (&acc)[2][2][4][2], const Unit& u, int wr, int wc, int fr, int fq) const {
#pragma unroll
        for (int ai = 0; ai < 2; ++ai)
#pragma unroll
            for (int m = 0; m < 4; ++m) {
                float* xr = x + (size_t)(u.pm * 256 + ai * 128 + wr * 64 + m * 16 + fr) * 2048 + u.pn * 256 + wc * 32 + 4 * fq;
#pragma unroll
                for (int bj = 0; bj < 2; ++bj)
#pragma unroll
                    for (int n = 0; n < 2; ++n) *(f32x4*)(xr + bj * 128 + n * 16) = acc[ai][bj][m][n];
            }
    }
    __device__ __forceinline__ void operator()(const f32x4 (&acc)[2][2][4][2], const Unit& u, int wr, int wc, int fr, int fq) const {
#pragma unroll
        for (int ai = 0; ai < 2; ++ai)
#pragma unroll
            for (int m = 0; m < 4; ++m) {
                const int row = u.pm * 256 + ai * 128 + wr * 64 + m * 16 + fr;
                float* xr = x + (size_t)row * 2048 + u.pn * 256 + wc * 32 + 4 * fq;
#pragma unroll
                for (int bj = 0; bj < 2; ++bj)
#pragma unroll
                    for (int n = 0; n < 2; ++n) { f32x4* p = (f32x4*)(xr + bj * 128 + n * 16); *p = *p + acc[ai][bj][m][n]; }
                asm volatile("" ::: "memory");
            }
    }
};
struct EpiSwi {
    static constexpr bool PERM = true, AFTER_DRAIN = false, INIT_ACC = false;
    bf16_t* act;
    __device__ __forceinline__ void operator()(const f32x4 (&acc)[2][2][4][2], const Unit& u, int wr, int wc, int fr, int fq) const {
#pragma unroll
        for (int ai = 0; ai < 2; ++ai)
#pragma unroll
            for (int m = 0; m < 4; ++m) {
                const int row = u.pm * 256 + ai * 128 + wr * 64 + m * 16 + fr;
                float a[8];
#pragma unroll
                for (int n = 0; n < 2; ++n)
#pragma unroll
                    for (int e = 0; e < 4; ++e) { const float g = acc[ai][0][m][n][e], up = acc[ai][1][m][n][e];
                        a[4 * n + e] = g * __builtin_amdgcn_rcpf(1.0f + __expf(-g)) * up; }
                u32x4 w; w.x = cvtpk(a[0], a[1]); w.y = cvtpk(a[2], a[3]); w.z = cvtpk(a[4], a[5]); w.w = cvtpk(a[6], a[7]);
                *(u32x4*)(act + (size_t)row * 5632 + 128 * u.pn + 32 * wc + 8 * fq) = w;
                asm volatile("" ::: "memory");
            }
    }
};

struct EpiResN {
    static constexpr bool PERM = false, AFTER_DRAIN = false, INIT_ACC = true;
    const float* xin; float* x; bf16_t* xg; const float* g; float* ssq;
    __device__ __forceinline__ void init(f32x4 (&acc)[2][2][4][2], const Unit& u, int wr, int wc, int fr, int fq) const {
#pragma unroll
        for (int ai = 0; ai < 2; ++ai)
#pragma unroll
            for (int m = 0; m < 4; ++m) {
                const float* xr = xin + (size_t)(u.pm * 256 + ai * 128 + wr * 64 + m * 16 + fr) * 2048 + u.pn * 256 + wc * 32 + 4 * fq;
#pragma unroll
                for (int bj = 0; bj < 2; ++bj)
#pragma unroll
                    for (int n = 0; n < 2; ++n) acc[ai][bj][m][n] = *(const f32x4*)(xr + bj * 128 + n * 16);
            }
    }
    __device__ __forceinline__ void store_only(const f32x4 (&acc)[2][2][4][2], const Unit& u, int wr, int wc, int fr, int fq) const {
        const int col0 = u.pn * 256 + wc * 32 + 4 * fq;
        f32x4 gv[2][2];
#pragma unroll
        for (int bj = 0; bj < 2; ++bj)
#pragma unroll
            for (int n = 0; n < 2; ++n) gv[bj][n] = *(const f32x4*)(g + col0 + bj * 128 + n * 16);
#pragma unroll
        for (int ai = 0; ai < 2; ++ai)
#pragma unroll
            for (int m = 0; m < 4; ++m) {
                const int row = u.pm * 256 + ai * 128 + wr * 64 + m * 16 + fr;
                float* xr = x + (size_t)row * 2048 + col0; bf16_t* hr = xg + (size_t)row * 2048 + col0;
                float ss = 0.f;
#pragma unroll
                for (int bj = 0; bj < 2; ++bj)
#pragma unroll
                    for (int n = 0; n < 2; ++n) {
                        const f32x4 v = acc[ai][bj][m][n]; *(f32x4*)(xr + bj * 128 + n * 16) = v;
                        const f32x4 gg = gv[bj][n];
                        ss += (v[0] * v[0] + v[1] * v[1]) + (v[2] * v[2] + v[3] * v[3]);
                        const f32x4 y = v * gg;
                        typedef unsigned u32x2t __attribute__((ext_vector_type(2)));
                        u32x2t w; w.x = cvtpk(y[0], y[1]); w.y = cvtpk(y[2], y[3]);
                        *(u32x2t*)(hr + bj * 128 + n * 16) = w;
                    }
                ss += __shfl_xor(ss, 16); ss += __shfl_xor(ss, 32);
                if (fq == 0) ssq[(size_t)row * 32 + u.pn * 4 + wc] = ss;
                asm volatile("" ::: "memory");
            }
    }
    __device__ __forceinline__ void operator()(const f32x4 (&acc)[2][2][4][2], const Unit& u, int wr, int wc, int fr, int fq) const {
        const int col0 = u.pn * 256 + wc * 32 + 4 * fq;
#pragma unroll
        for (int ai = 0; ai < 2; ++ai)
#pragma unroll
            for (int m = 0; m < 4; ++m) {
                const int row = u.pm * 256 + ai * 128 + wr * 64 + m * 16 + fr;
                float* xr = x + (size_t)row * 2048 + col0; bf16_t* hr = xg + (size_t)row * 2048 + col0;
                float ss = 0.f;
#pragma unroll
                for (int bj = 0; bj < 2; ++bj)
#pragma unroll
                    for (int n = 0; n < 2; ++n) {
                        f32x4* p = (f32x4*)(xr + bj * 128 + n * 16); const f32x4 v = *(const f32x4*)(xin + (size_t)row * 2048 + col0 + bj * 128 + n * 16) + acc[ai][bj][m][n]; *p = v;
                        const f32x4 gg = *(const f32x4*)(g + col0 + bj * 128 + n * 16);
                        ss += (v[0] * v[0] + v[1] * v[1]) + (v[2] * v[2] + v[3] * v[3]);
                        const f32x4 y = v * gg;
                        typedef unsigned u32x2t __attribute__((ext_vector_type(2)));
                        u32x2t w; w.x = cvtpk(y[0], y[1]); w.y = cvtpk(y[2], y[3]);
                        *(u32x2t*)(hr + bj * 128 + n * 16) = w;
                    }
                ss += __shfl_xor(ss, 16); ss += __shfl_xor(ss, 32);
                if (fq == 0) ssq[(size_t)row * 32 + u.pn * 4 + wc] = ss;
                asm volatile("" ::: "memory");
            }
    }
};
struct EpiSwiR {
    static constexpr bool PERM = true, AFTER_DRAIN = false, INIT_ACC = false;
    bf16_t* act; const float* rstd;
    __device__ __forceinline__ void operator()(const f32x4 (&acc)[2][2][4][2], const Unit& u, int wr, int wc, int fr, int fq) const {
        const float* rp = rstd + u.pm * 256 + wr * 64 + fr;
        float rsv[8];
#pragma unroll
        for (int g = 0; g < 8; ++g) rsv[g] = rp[(g >> 2) * 128 + (g & 3) * 16];
#pragma unroll
        for (int ai = 0; ai < 2; ++ai)
#pragma unroll
            for (int m = 0; m < 4; ++m) {
                const int row = u.pm * 256 + ai * 128 + wr * 64 + m * 16 + fr;
                const float rs = rsv[ai * 4 + m];
                float a[8];
#pragma unroll
                for (int n = 0; n < 2; ++n)
#pragma unroll
                    for (int e = 0; e < 4; ++e) { const float g = acc[ai][0][m][n][e] * rs, up = acc[ai][1][m][n][e] * rs;
                        a[4 * n + e] = g * __builtin_amdgcn_rcpf(1.0f + __expf(-g)) * up; }
                u32x4 w; w.x = cvtpk(a[0], a[1]); w.y = cvtpk(a[2], a[3]); w.z = cvtpk(a[4], a[5]); w.w = cvtpk(a[6], a[7]);
                *(u32x4*)(act + (size_t)row * 5632 + 128 * u.pn + 32 * wc + 8 * fq) = w;
                if (m & 1) asm volatile("" ::: "memory");
            }
    }
};

template <class Epi, class Sched, bool ALIGN_EPI = false, bool SP2 = false>
__device__ __forceinline__ void gemm_phase(PG8_LAS unsigned char* lds, const Gemm g, const Sched& S, const Epi& E) {
    const int tid = tid_opaque(), wid = __builtin_amdgcn_readfirstlane(tid >> 6), lane = tid & 63, wr = wid >> 2, wc = wid & 3, fr = lane & 15, fq = lane >> 4;
    const int K = g.K, nt = K / BK;
    unsigned voffA[2], voffB[2];
#pragma unroll
    for (int i = 0; i < 2; ++i) { int R, C; stage_rc(tid * 16 + i * 8192, R, C); const int Rb = Epi::PERM ? ((R & ~31) + perm32(R & 31)) : R;
        voffA[i] = (unsigned)(R * K + C) * 2u; voffB[i] = (unsigned)(Rb * K + C) * 2u; }
    const size_t kstep = (size_t)(BK * 2);
    const size_t hstep = (size_t)HALF * K * 2;
    const size_t tstep = 2 * hstep;
    const unsigned ldsw = (unsigned)wid * 1024u;
    const int aoff = lds_byte(wr * 64 + fr, fq * 8), boff = lds_byte(wc * 32 + fr, fq * 8);
#define PG8_SA(b, h) (((b) * 2 + (h)) * HTB)
#define PG8_SB(b, h) ((4 + (b) * 2 + (h)) * HTB)
#define PG8_STAGE(bufoff, gbase, voff) do { _Pragma("unroll") for (int _i = 0; _i < 2; ++_i) \
        __builtin_amdgcn_global_load_lds((const unsigned*)((const char*)(gbase) + (voff)[_i]), (PG8_LAS unsigned*)(lds + (bufoff) + ldsw + _i * 8192), 16, 0, 0); } while (0)
#define PG8_LDA(dst, b, h) do { _Pragma("unroll") for (int m = 0; m < 4; ++m) _Pragma("unroll") for (int k = 0; k < 2; ++k) dst[m][k] = *(const PG8_LAS bf16x8*)(lds + PG8_SA(b, h) + aoff + m * 2048 + k * 1024); } while (0)
#define PG8_LDB(dst, b, h) do { _Pragma("unroll") for (int n = 0; n < 2; ++n) _Pragma("unroll") for (int k = 0; k < 2; ++k) dst[n][k] = *(const PG8_LAS bf16x8*)(lds + PG8_SB(b, h) + boff + n * 2048 + k * 1024); } while (0)
#define PG8_MMA(ai, bj, At, Bt) do { __builtin_amdgcn_s_setprio(1); _Pragma("unroll") for (int m = 0; m < 4; ++m) _Pragma("unroll") for (int n = 0; n < 2; ++n) _Pragma("unroll") for (int k = 0; k < 2; ++k) \
        acc[ai][bj][m][n] = __builtin_amdgcn_mfma_f32_16x16x32_bf16(Bt[n][k], At[m][k], acc[ai][bj][m][n], 0, 0, 0); __builtin_amdgcn_s_setprio(0); } while (0)
#define PG8_WAIT_V(n) asm volatile("s_waitcnt vmcnt(" #n ")" ::: "memory")
#define PG8_WAIT_L(n) asm volatile("s_waitcnt lgkmcnt(" #n ")" ::: "memory")
#define PG8_BAR __builtin_amdgcn_s_barrier()
#define PG8_SCHED __builtin_amdgcn_sched_barrier(0)
    Unit cur, nxt; int ui = 0;
    if (!S.next(0, cur)) return;
    f32x4 acc[2][2][4][2];
#pragma unroll
    for (int a = 0; a < 2; ++a)
#pragma unroll
        for (int b = 0; b < 2; ++b)
#pragma unroll
            for (int m = 0; m < 4; ++m)
#pragma unroll
                for (int n = 0; n < 2; ++n) acc[a][b][m][n] = (f32x4){0.f, 0.f, 0.f, 0.f};
    if constexpr (Epi::INIT_ACC) E.init(acc, cur, wr, wc, fr, fq);
    bf16x8 At[4][2], B0[2][2], B1[2][2];
    const char* cA = (const char*)g.A + (size_t)cur.pm * tstep; const char* cB = (const char*)g.Bt + (size_t)cur.pn * tstep;
    S.a_ready(cur);
    if constexpr (SP2) {
        PG8_STAGE(PG8_SB(0, 0), cB, voffB); PG8_STAGE(PG8_SB(0, 1), cB + hstep, voffB); PG8_STAGE(PG8_SA(0, 0), cA, voffA); PG8_STAGE(PG8_SA(0, 1), cA + hstep, voffA);
        if (wr == 1) PG8_BAR;
        PG8_WAIT_V(2); PG8_BAR;
        PG8_STAGE(PG8_SB(1, 0), cB + kstep, voffB); PG8_STAGE(PG8_SA(1, 0), cA + kstep, voffA); PG8_STAGE(PG8_SB(1, 1), cB + hstep + kstep, voffB);
        PG8_WAIT_V(6); PG8_BAR;
    } else {
        PG8_STAGE(PG8_SB(0, 0), cB, voffB); PG8_STAGE(PG8_SA(0, 0), cA, voffA); PG8_STAGE(PG8_SB(0, 1), cB + hstep, voffB); PG8_STAGE(PG8_SA(0, 1), cA + hstep, voffA);
        if (wr == 1) PG8_BAR;
        PG8_WAIT_V(4); PG8_BAR;
        PG8_STAGE(PG8_SB(1, 0), cB + kstep, voffB); PG8_STAGE(PG8_SA(1, 0), cA + kstep, voffA); PG8_STAGE(PG8_SB(1, 1), cB + hstep + kstep, voffB);
        PG8_WAIT_V(6); PG8_BAR;
    }
    for (;;) {
        const bool has_next = S.next(ui + 1, nxt);
        const char* nA = has_next ? (const char*)g.A + (size_t)nxt.pm * tstep : cA; const char* nB = has_next ? (const char*)g.Bt + (size_t)nxt.pn * tstep : cB;
        for (int t = 0; t < nt; t += 2) {
            const bool last = (t == nt - 2);
            const char* a1 = cA + (size_t)(t + 1) * kstep;
            const char* a2 = last ? nA : cA + (size_t)(t + 2) * kstep; const char* b2 = last ? nB : cB + (size_t)(t + 2) * kstep;
            const char* a3 = a2 + kstep; const char* b3 = b2 + kstep;
            if (last && has_next) S.a_ready(nxt);
            if constexpr (SP2) {
            PG8_LDB(B0, 0, 0); PG8_LDB(B1, 0, 1); PG8_SCHED; PG8_LDA(At, 0, 0); PG8_STAGE(PG8_SA(1, 1), a1 + hstep, voffA);
            PG8_WAIT_V(8); PG8_WAIT_L(0); PG8_BAR; PG8_MMA(0, 0, At, B0); PG8_MMA(0, 1, At, B1); PG8_BAR; PG8_SCHED;
            PG8_LDA(At, 0, 1); PG8_STAGE(PG8_SB(0, 0), b2, voffB); PG8_STAGE(PG8_SB(0, 1), b2 + hstep, voffB); PG8_STAGE(PG8_SA(0, 0), a2, voffA);
            PG8_WAIT_V(8); PG8_WAIT_L(0); PG8_BAR; PG8_MMA(1, 0, At, B0); PG8_MMA(1, 1, At, B1); PG8_BAR; PG8_SCHED;
            PG8_LDB(B0, 1, 0); PG8_LDB(B1, 1, 1); PG8_SCHED; PG8_LDA(At, 1, 0); PG8_STAGE(PG8_SA(0, 1), a2 + hstep, voffA);
            PG8_WAIT_V(8); PG8_WAIT_L(0); PG8_BAR; PG8_MMA(0, 0, At, B0); PG8_MMA(0, 1, At, B1); PG8_BAR; PG8_SCHED;
            PG8_LDA(At, 1, 1); PG8_STAGE(PG8_SB(1, 0), b3, voffB); PG8_STAGE(PG8_SB(1, 1), b3 + hstep, voffB); PG8_STAGE(PG8_SA(1, 0), a3, voffA);
            PG8_WAIT_V(8); PG8_WAIT_L(0); PG8_BAR; PG8_MMA(1, 0, At, B0); PG8_MMA(1, 1, At, B1); PG8_BAR; PG8_SCHED;
            } else {
            PG8_LDB(B0, 0, 0); PG8_SCHED; PG8_LDA(At, 0, 0); PG8_STAGE(PG8_SA(1, 1), a1 + hstep, voffA);
            PG8_WAIT_L(8); PG8_BAR; PG8_WAIT_L(0); PG8_MMA(0, 0, At, B0); PG8_BAR; PG8_SCHED;
            PG8_LDB(B1, 0, 1); PG8_STAGE(PG8_SB(0, 0), b2, voffB);
            PG8_BAR; PG8_WAIT_L(0); PG8_MMA(0, 1, At, B1); PG8_BAR;
            PG8_LDA(At, 0, 1); PG8_STAGE(PG8_SA(0, 0), a2, voffA);
            PG8_BAR; PG8_WAIT_L(0); PG8_MMA(1, 0, At, B0); PG8_BAR; PG8_SCHED;
            PG8_STAGE(PG8_SB(0, 1), b2 + hstep, voffB);
            PG8_WAIT_V(6); PG8_BAR; PG8_MMA(1, 1, At, B1); PG8_BAR;
            PG8_LDB(B0, 1, 0); PG8_SCHED; PG8_LDA(At, 1, 0); PG8_STAGE(PG8_SA(0, 1), a2 + hstep, voffA);
            PG8_WAIT_L(8); PG8_BAR; PG8_WAIT_L(0); PG8_MMA(0, 0, At, B0); PG8_BAR; PG8_SCHED;
            PG8_LDB(B1, 1, 1); PG8_STAGE(PG8_SB(1, 0), b3, voffB);
            PG8_BAR; PG8_WAIT_L(0); PG8_MMA(0, 1, At, B1); PG8_BAR;
            PG8_LDA(At, 1, 1); PG8_STAGE(PG8_SA(1, 0), a3, voffA);
            PG8_BAR; PG8_WAIT_L(0); PG8_MMA(1, 0, At, B0); PG8_BAR; PG8_SCHED;
            PG8_STAGE(PG8_SB(1, 1), b3 + hstep, voffB);
            PG8_WAIT_V(6); PG8_BAR; PG8_MMA(1, 1, At, B1); PG8_BAR;
            }
        }
        if constexpr (ALIGN_EPI) { if (wr == 0) PG8_BAR; }
        if constexpr (!Epi::AFTER_DRAIN) { if constexpr (Epi::INIT_ACC) { if (ui == 0) E.store_only(acc, cur, wr, wc, fr, fq); else E(acc, cur, wr, wc, fr, fq); } else { E(acc, cur, wr, wc, fr, fq); } S.done(cur); }
        if (!has_next) break;
#pragma unroll
        for (int a = 0; a < 2; ++a)
#pragma unroll
            for (int b = 0; b < 2; ++b)
#pragma unroll
                for (int m = 0; m < 4; ++m)
#pragma unroll
                    for (int n = 0; n < 2; ++n) acc[a][b][m][n] = (f32x4){0.f, 0.f, 0.f, 0.f};
        cur = nxt; cA = nA; cB = nB; ++ui;
        if constexpr (ALIGN_EPI) { if (wr == 1) PG8_BAR; }
    }
    PG8_WAIT_V(0);
    if constexpr (!ALIGN_EPI) { if (wr == 0) PG8_BAR; }
    PG8_BAR;
    if constexpr (Epi::AFTER_DRAIN) { E.fused(acc, cur, wr, wc, fr, fq, lds, wid, lane); S.done(cur); }
#undef PG8_SA
#undef PG8_SB
#undef PG8_STAGE
#undef PG8_LDA
#undef PG8_LDB
#undef PG8_MMA
#undef PG8_WAIT_V
#undef PG8_WAIT_L
#undef PG8_BAR
#undef PG8_SCHED
}
}
namespace att {
using pg8::bf16_t; using pg8::bf16x8; using pg8::cvtpk; using pg8::f2bf;
typedef float f32x16 __attribute__((ext_vector_type(16)));
typedef unsigned u32x4 __attribute__((ext_vector_type(4)));
constexpr int KROWB = 272, VROWB = 320, KBUF = 64 * KROWB, VBUF = 64 * VROWB;
constexpr int L_K = 0, L_V = 2 * KBUF, L_C = L_V + 2 * VBUF, L_KM = L_C + 8192, L_FLAG = L_KM + 4096, L_UNIT = L_FLAG + 64, L_WS = L_UNIT + 64, L_END = L_WS + 8 * 128;
constexpr float NEG = -1.0e30f, LOG2E = 1.4426950408889634f, LN2 = 0.6931471805599453f;
DI int crow(int i, int h) { return (i & 3) + 8 * (i >> 2) + 4 * h; }
#define MFMA32(a, b, c) __builtin_amdgcn_mfma_f32_32x32x16_bf16((a), (b), (c), 0, 0, 0)
DI bf16x8 pack8(const f32x16& x, int base) {
    u32x4 p; p.x = cvtpk(x[base], x[base + 1]); p.y = cvtpk(x[base + 2], x[base + 3]); p.z = cvtpk(x[base + 4], x[base + 5]); p.w = cvtpk(x[base + 6], x[base + 7]);
    return __builtin_bit_cast(bf16x8, p);
}
DI float bf2f(short v) { return __uint_as_float(((unsigned)(unsigned short)v) << 16); }
DI float ex2(float v) { return __builtin_amdgcn_exp2f(v); }
DI float xh_max(float v) { auto rr = __builtin_amdgcn_permlane32_swap(__float_as_uint(v), __float_as_uint(v), false, false); return fmaxf(__uint_as_float(rr[0]), __uint_as_float(rr[1])); }
DI float xh_sum(float v) { auto rr = __builtin_amdgcn_permlane32_swap(__float_as_uint(v), __float_as_uint(v), false, false); return __uint_as_float(rr[0]) + __uint_as_float(rr[1]); }
typedef short s16x4v __attribute__((ext_vector_type(4)));
DI bf16x8 vtr8(const unsigned char* p) {
    typedef __attribute__((address_space(3))) s16x4v* lp;
    const s16x4v lo = __builtin_amdgcn_ds_read_tr16_b64_v4i16((lp)(p)), hi = __builtin_amdgcn_ds_read_tr16_b64_v4i16((lp)(p + 4 * VROWB));
    return __builtin_shufflevector(lo, hi, 0, 1, 2, 3, 4, 5, 6, 7);
}
struct AttnP { const bf16_t* z; const bf16_t* vT; bf16_t* mixed; float* dA; float* dB; const float* cfox; const unsigned* kmax2; const float* gsub;
               const float* lq1; const float* lk1; const float* lq2; const float* lk2; float lam_init; };

typedef float f32x4a __attribute__((ext_vector_type(4)));
DI void scale_rows(f32x16 (&o)[4], float per_q, unsigned char* lds, int wid, int r, int h) {
    float* wsc = (float*)(lds + L_WS) + wid * 32;
    if (h == 0) wsc[r] = per_q;
#pragma unroll
    for (int g = 0; g < 4; ++g) { const f32x4a a = *(const f32x4a*)(wsc + 8 * g + 4 * h);
#pragma unroll
        for (int d = 0; d < 4; ++d) { o[d][4 * g] *= a[0]; o[d][4 * g + 1] *= a[1]; o[d][4 * g + 2] *= a[2]; o[d][4 * g + 3] *= a[3]; } }
}
template <int MODE, int KS0, int NKS>
DI void attn_pass(unsigned char* lds, const AttnP& P, int mixer, int b, int hd, int qb, int q0, int NT, int wrow, f32x16 (&o)[4], float& l_tot, unsigned sel, float scale2) {
    const int tid = tid_opaque(), lane = tid & 63, r = lane & 31, h = lane >> 5;
    const int wid = __builtin_amdgcn_readfirstlane(tid >> 6);
    const int qw0 = q0 + 32 * wrow, myq = qw0 + r, rowbase = b * SEQ;
    const bf16_t* qptr = P.z + (size_t)(rowbase + myq) * ZC + mixer * 1536 + hd * 128;
    bf16x8 qf[NKS];
#pragma unroll
    for (int s = 0; s < NKS; ++s) qf[s] = *(const bf16x8*)(qptr + 16 * (KS0 + s) + 8 * h);
    const bf16_t* kbase = P.z + (size_t)rowbase * ZC + mixer * 1536 + 512 + hd * 128;
    const bf16_t* vbase = P.z + (size_t)rowbase * ZC + mixer * 1536 + 1024 + hd * 128;
    const int kap = (r & 19) | ((r & 4) << 1) | ((r & 8) >> 1);
#pragma unroll
    for (int d = 0; d < 4; ++d)
#pragma unroll
        for (int i = 0; i < 16; ++i) o[d][i] = 0.f;
    float m_run = NEG, l_run = 0.f, carry = 0.f;
    float cq2 = 0.f;
    if (MODE == 0) cq2 = ((const float*)(lds + L_C))[myq];
    float smaxl = 0.f;
    if (MODE == 0) {
        float q2 = 0.f;
#pragma unroll
        for (int s = 0; s < NKS; ++s)
#pragma unroll
            for (int j = 0; j < 8; ++j) q2 += fabsf(bf2f(qf[s][j]));
        q2 = xh_sum(q2);
        smaxl = q2 * __uint_as_float(sel) * scale2 * 1.01f + 0.01f;
    }
    bf16x8 tf0, tf1, ones;
    if (MODE == 3) {
#pragma unroll
        for (int j = 0; j < 8; ++j) { tf0[j] = ((8 * h + j) > kap) ? (short)0x3F80 : (short)0; tf1[j] = ((16 + 8 * h + j) > kap) ? (short)0x3F80 : (short)0; ones[j] = (short)0x3F80; }
    }
    const int kr_row = tid >> 4, kr_col = tid & 15;
    struct TileRegs { u32x4 k0, k1, v0, v1; };
    TileRegs RA, RB;
#define ATT_GLOAD(t_, R_) do { const int k0_ = 64 * (t_); \
        R_.k0 = *(const u32x4*)(kbase + (size_t)(k0_ + kr_row) * ZC + kr_col * 8); R_.k1 = *(const u32x4*)(kbase + (size_t)(k0_ + kr_row + 32) * ZC + kr_col * 8); \
        R_.v0 = *(const u32x4*)(vbase + (size_t)(k0_ + kr_row) * ZC + kr_col * 8); R_.v1 = *(const u32x4*)(vbase + (size_t)(k0_ + kr_row + 32) * ZC + kr_col * 8); } while (0)
#define ATT_SSTORE(buf_, R_) do { unsigned char* kb_ = lds + L_K + (buf_) * KBUF; unsigned char* vb_ = lds + L_V + (buf_) * VBUF; \
        *(u32x4*)(kb_ + kr_row * KROWB + kr_col * 16) = R_.k0; *(u32x4*)(kb_ + (kr_row + 32) * KROWB + kr_col * 16) = R_.k1; \
        *(u32x4*)(vb_ + kr_row * VROWB + kr_col * 16) = R_.v0; *(u32x4*)(vb_ + (kr_row + 32) * VROWB + kr_col * 16) = R_.v1; } while (0)
#define ATT_TILE(it_) ((MODE == 3 || MODE == 0) ? (NT - 1 - (it_)) : (it_))
    ATT_GLOAD(ATT_TILE(0), RA); ATT_SSTORE(0, RA); __syncthreads();
    constexpr bool DEEP = (MODE == 1 || MODE == 2);
    constexpr int PF = DEEP ? 2 : 1;
    if (DEEP && NT > 1) ATT_GLOAD(ATT_TILE(1), RA);
    bool wdone = false;
    auto att_iter = [&](const int it, TileRegs& LD_, TileRegs& ST_) -> bool {
        const int cur = it & 1, t = ATT_TILE(it), key0 = 64 * t;
        const int lim = myq - key0 - 8 * h; const float limf = (float)lim;
        if (it + PF < NT) ATT_GLOAD(ATT_TILE(it + PF), LD_);
        bool active;
        if (MODE == 3) active = (key0 < qw0 + 31) && !wdone; else if (MODE == 0) active = (key0 <= qw0 + 31) && !wdone; else active = (key0 <= qw0 + 31);
        bool past = false;
        if (MODE == 1) { past = (t >> 2) < qb; if (past) active = __any((int)((sel >> (t >> 2)) & 1u)) != 0; }
        if (active) {
            const unsigned char* Kb = lds + L_K + cur * KBUF; const unsigned char* Vb = lds + L_V + cur * VBUF;
            f32x16 s0, s1;
#pragma unroll
            for (int i = 0; i < 16; ++i) { s0[i] = 0.f; s1[i] = 0.f; }
            __builtin_amdgcn_s_setprio(1);
#pragma unroll
            for (int s = 0; s < NKS; ++s) {
                const bf16x8 ka0 = *(const bf16x8*)(Kb + kap * KROWB + (16 * (KS0 + s) + 8 * h) * 2);
                const bf16x8 ka1 = *(const bf16x8*)(Kb + (32 + kap) * KROWB + (16 * (KS0 + s) + 8 * h) * 2);
                s0 = MFMA32(ka0, qf[s], s0); s1 = MFMA32(ka1, qf[s], s1);
            }
            __builtin_amdgcn_s_setprio(0);
            bf16x8 pa0, pa1, pa2, pa3;
            if (MODE != 3) {
                if (MODE == 0) {
                    const float* cl = (const float*)(lds + L_C) + key0 + 8 * h;
#pragma unroll
                    for (int i = 0; i < 16; ++i) { s0[i] = s0[i] * scale2 + (cq2 - cl[16 * (i >> 3) + (i & 7)]); s1[i] = s1[i] * scale2 + (cq2 - cl[32 + 16 * (i >> 3) + (i & 7)]); }
                } else {
                    const float blk_bias = (MODE == 1 && past && !((sel >> (t >> 2)) & 1u)) ? NEG : 0.f;
#pragma unroll
                    for (int i = 0; i < 16; ++i) { s0[i] = fmaf(s0[i], scale2, blk_bias); s1[i] = fmaf(s1[i], scale2, blk_bias); }
                }
                if (MODE == 1 && past) {
                } else if (key0 + 63 > qw0) {
#pragma unroll
                    for (int i = 0; i < 16; ++i) {
                        const float m0 = __builtin_amdgcn_fmed3f((float)(16 * (i >> 3) + (i & 7)) - limf, 0.f, 1.f), m1 = __builtin_amdgcn_fmed3f((float)(32 + 16 * (i >> 3) + (i & 7)) - limf, 0.f, 1.f);
                        s0[i] = fmaf(m0, NEG, s0[i]); s1[i] = fmaf(m1, NEG, s1[i]); }
                }
                float mloc = s0[0];
#pragma unroll
                for (int i = 0; i < 16; ++i) { mloc = fmaxf(mloc, s0[i]); mloc = fmaxf(mloc, s1[i]); }
                mloc = xh_max(mloc);
                if (__any((int)(mloc > m_run + 8.0f))) {
                    const float m_new = fmaxf(m_run, mloc);
                    const float alpha = ex2(m_run - m_new);
                    m_run = m_new; l_run *= alpha;
                    scale_rows(o, alpha, lds, wid, r, h);
                }
                float lsum = 0.f;
#pragma unroll
                for (int i = 0; i < 16; ++i) { s0[i] = ex2(s0[i] - m_run); s1[i] = ex2(s1[i] - m_run); lsum += s0[i] + s1[i]; }
                l_run += lsum;
                pa0 = pack8(s0, 0); pa1 = pack8(s0, 8); pa2 = pack8(s1, 0); pa3 = pack8(s1, 8);
            } else {
                f32x16 lb, w;
                float lsum = 0.f;
#pragma unroll
                for (int i = 0; i < 16; ++i) {
                    const float zv = s1[i] * scale2, e = ex2(-fabsf(zv) * LOG2E), tt = __builtin_amdgcn_logf(1.0f + e) * LN2;
                    const float lbv = fminf(zv, 0.f) - tt; const bool ok = (32 + 16 * (i >> 3) + (i & 7)) < lim;
                    const float Lv = ok ? (lbv - zv) : 0.f; lb[i] = ok ? lbv : NEG; s1[i] = Lv; lsum += Lv; }
                const bf16x8 x1a = pack8(s1, 0), x1b = pack8(s1, 8);
#pragma unroll
                for (int i = 0; i < 16; ++i) w[i] = 0.f;
                w = MFMA32(tf0, x1a, w); w = MFMA32(tf1, x1b, w);
#pragma unroll
                for (int i = 0; i < 16; ++i) s1[i] = ex2((lb[i] + carry + w[i]) * LOG2E);
#pragma unroll
                for (int i = 0; i < 16; ++i) {
                    const float zv = s0[i] * scale2, e = ex2(-fabsf(zv) * LOG2E), tt = __builtin_amdgcn_logf(1.0f + e) * LN2;
                    const float lbv = fminf(zv, 0.f) - tt; const bool ok = (16 * (i >> 3) + (i & 7)) < lim;
                    const float Lv = ok ? (lbv - zv) : 0.f; lb[i] = ok ? lbv : NEG; s0[i] = Lv; lsum += Lv; }
                const bf16x8 x0a = pack8(s0, 0), x0b = pack8(s0, 8);
#pragma unroll
                for (int i = 0; i < 16; ++i) w[i] = 0.f;
                w = MFMA32(tf0, x0a, w); w = MFMA32(tf1, x0b, w); w = MFMA32(ones, x1a, w); w = MFMA32(ones, x1b, w);
#pragma unroll
                for (int i = 0; i < 16; ++i) s0[i] = ex2((lb[i] + carry + w[i]) * LOG2E);
                lsum = xh_sum(lsum);
                carry += lsum;
                pa0 = pack8(s0, 0); pa1 = pack8(s0, 8); pa2 = pack8(s1, 0); pa3 = pack8(s1, 8);
            }
            __builtin_amdgcn_s_setprio(1);
#pragma unroll
            for (int d = 0; d < 4; ++d) {
                const unsigned char* vp = Vb + (8 * h + ((lane & 15) >> 2)) * VROWB + (32 * d + 16 * ((lane >> 4) & 1)) * 2 + 8 * (lane & 3);
                const bf16x8 v0 = vtr8(vp), v1 = vtr8(vp + 16 * VROWB), v2 = vtr8(vp + 32 * VROWB), v3 = vtr8(vp + 48 * VROWB);
                o[d] = MFMA32(pa0, v0, o[d]); o[d] = MFMA32(pa1, v1, o[d]); o[d] = MFMA32(pa2, v2, o[d]); o[d] = MFMA32(pa3, v3, o[d]);
            }
            __builtin_amdgcn_s_setprio(0);
        }
        if (it + 1 < NT) ATT_SSTORE(cur ^ 1, ST_);
        if (MODE == 3) {
            wdone = __all((int)(carry < -110.0f)) != 0;
            if (lane == 0) ((volatile unsigned*)(lds + L_FLAG))[(it & 1) * 8 + wid] = wdone ? 1u : 0u;
        }
        if (MODE == 0) {
            const float cprev = (key0 > 0) ? ((const float*)(lds + L_C))[key0 - 1] : 0.f;
            wdone = (key0 == 0) || (__all((int)((smaxl + cq2 - cprev) - m_run < -160.0f)) != 0);
            if (lane == 0) ((volatile unsigned*)(lds + L_FLAG))[(it & 1) * 8 + wid] = wdone ? 1u : 0u;
        }
        __syncthreads();
        if (MODE == 3 || MODE == 0) {
            const volatile unsigned* fl = (const volatile unsigned*)(lds + L_FLAG) + (it & 1) * 8;
            unsigned all = 1u;
#pragma unroll
            for (int w8 = 0; w8 < 8; ++w8) all &= fl[w8];
            if (all) return true;
        }
        return false;
    };
    for (int it = 0; it < NT; it += 2) {
        if (DEEP) { if (att_iter(it, RB, RA)) break; if (it + 1 < NT) { if (att_iter(it + 1, RA, RB)) break; } }
        else { if (att_iter(it, RA, RA)) break; if (it + 1 < NT) { if (att_iter(it + 1, RA, RA)) break; } }
    }
    l_tot = xh_sum(l_run);
#undef ATT_GLOAD
#undef ATT_SSTORE
#undef ATT_TILE
}

DI void store_o(const AttnP& P, const f32x16 (&o)[4], int mixer, int b, int hd, int qb) {
    const int tid = tid_opaque(), lane = tid & 63, r = lane & 31, h = lane >> 5, wid = tid >> 6;
    bf16_t* mp = P.mixed + (size_t)(b * SEQ + qb * 256 + 32 * wid) * DM + mixer * 512 + hd * 128 + r;
#pragma unroll
    for (int d = 0; d < 4; ++d)
#pragma unroll
        for (int i = 0; i < 16; ++i) mp[(size_t)crow(i, h) * DM + 32 * d] = f2bf(o[d][i]);
}
DI void attn_unit(unsigned char* lds, const AttnP& P, int mixer, int bh, int qb) {
    const int tid = tid_opaque(), lane = tid & 63, r = lane & 31, h = lane >> 5;
    const int wid = __builtin_amdgcn_readfirstlane(tid >> 6);
    const int b = bh >> 2, hd = bh & 3;
    const float sc128 = 0.08838834764831845f;
    f32x16 o[4]; float ltot = 1.f;
    if (mixer == 0) {
        float* cl = (float*)(lds + L_C);
        for (int t = tid; t < qb * 256 + 256; t += 512) cl[t] = P.cfox[bh * SEQ + t] * LOG2E;
        __syncthreads();
        attn_pass<0, 0, 8>(lds, P, 0, b, hd, qb, qb * 256, 4 * (qb + 1), wid, o, ltot, P.kmax2[bh], sc128 * LOG2E);
        scale_rows(o, 1.0f / ltot, lds, wid, r, h);
        store_o(P, o, 0, b, hd, qb);
    } else if (mixer == 1) {
        float* km = (float*)(lds + L_KM); float* part = (float*)(lds + L_K);
        {
            const int c8 = tid & 15, rg = tid >> 4;
            for (int n = 0; n < qb; ++n) {
                float a8[8];
#pragma unroll
                for (int j = 0; j < 8; ++j) a8[j] = 0.f;
                const bf16_t* kp = P.z + (size_t)(b * SEQ + n * 256 + rg) * ZC + 1536 + 512 + hd * 128 + c8 * 8;
#pragma unroll
                for (int i = 0; i < 8; ++i) { const bf16x8 v = *(const bf16x8*)(kp + (size_t)(32 * i) * ZC);
#pragma unroll
                    for (int j = 0; j < 8; ++j) a8[j] += bf2f(v[j]); }
#pragma unroll
                for (int j = 0; j < 8; ++j) part[rg * 128 + c8 * 8 + j] = a8[j];
                __syncthreads();
                if (tid < 128) { float s = 0.f;
#pragma unroll 8
                    for (int g = 0; g < 32; ++g) s += part[g * 128 + tid];
                    km[n * 128 + tid] = s * (1.0f / 256.0f); }
                __syncthreads();
            }
        }
        unsigned sel = 0u;
        {
            const bf16_t* qptr = P.z + (size_t)(b * SEQ + qb * 256 + 32 * wid + r) * ZC + 1536 + hd * 128;
            bf16x8 qv[8];
#pragma unroll
            for (int s = 0; s < 8; ++s) qv[s] = *(const bf16x8*)(qptr + 16 * s + 8 * h);
            float gate[8];
#pragma unroll
            for (int n = 0; n < 8; ++n) {
                gate[n] = -INFINITY;
                if (n < qb) {
                    float g = 0.f;
#pragma unroll
                    for (int s = 0; s < 8; ++s) { const float* kk = km + n * 128 + 16 * s + 8 * h;
#pragma unroll
                        for (int j = 0; j < 8; ++j) g += bf2f(qv[s][j]) * kk[j]; }
                    g = xh_sum(g);
                    gate[n] = g;
                }
            }
#pragma unroll
            for (int pick = 0; pick < 3; ++pick) {
                float best = -INFINITY; int bi = -1;
#pragma unroll
                for (int n = 0; n < 8; ++n) { const bool cand = (n < qb) && !((sel >> n) & 1u) && (gate[n] > best); if (cand) { best = gate[n]; bi = n; } }
                if (bi >= 0) sel |= (1u << bi);
            }
        }
        attn_pass<1, 0, 8>(lds, P, 1, b, hd, qb, qb * 256, 4 * (qb + 1), wid, o, ltot, sel, sc128 * LOG2E);
        scale_rows(o, 1.0f / ltot, lds, wid, r, h);
        store_o(P, o, 1, b, hd, qb);
    } else if (mixer == 2 || mixer == 4) {
        const int qb128 = (mixer == 2) ? qb : 8 + qb, q0 = qb128 * 128, NTd = 2 * (qb128 + 1), wrow = wid & 3;
        float d1 = P.lq1[lane] * P.lk1[lane], d2 = P.lq2[lane] * P.lk2[lane];
#pragma unroll
        for (int of = 1; of < 64; of <<= 1) { d1 += __shfl_xor(d1, of); d2 += __shfl_xor(d2, of); }
        const float lam = expf(d1) - expf(d2) + P.lam_init;
        if (wid < 4) attn_pass<2, 0, 4>(lds, P, 2, b, hd, 0, q0, NTd, wrow, o, ltot, 0u, 0.125f * LOG2E);
        else         attn_pass<2, 4, 4>(lds, P, 2, b, hd, 0, q0, NTd, wrow, o, ltot, 0u, 0.125f * LOG2E);
        scale_rows(o, 1.0f / ltot, lds, wid, r, h);
        float* ex = (float*)lds;
        __syncthreads();
        if (wid >= 4) {
#pragma unroll
            for (int d = 0; d < 4; ++d)
#pragma unroll
                for (int i = 0; i < 16; ++i) ex[((wrow * 4 + d) * 16 + i) * 64 + lane] = o[d][i];
        }
        __syncthreads();
        if (wid < 4) {
            float ss[16];
#pragma unroll
            for (int i = 0; i < 16; ++i) ss[i] = 0.f;
#pragma unroll
            for (int d = 0; d < 4; ++d)
#pragma unroll
                for (int i = 0; i < 16; ++i) { const float v = o[d][i] - lam * ex[((wrow * 4 + d) * 16 + i) * 64 + lane]; o[d][i] = v; ss[i] += v * v; }
#pragma unroll
            for (int i = 0; i < 16; ++i) {
#pragma unroll
                for (int of = 1; of < 32; of <<= 1) ss[i] += __shfl_xor(ss[i], of);
                ss[i] = (1.0f - P.lam_init) / sqrtf(ss[i] * (1.0f / 128.0f) + 1e-5f); }
            bf16_t* mp = P.mixed + (size_t)(b * SEQ + q0 + 32 * wrow) * DM + 2 * 512 + hd * 128 + r;
#pragma unroll
            for (int d = 0; d < 4; ++d) { const float g = P.gsub[32 * d + r];
#pragma unroll
                for (int i = 0; i < 16; ++i) mp[(size_t)crow(i, h) * DM + 32 * d] = f2bf(o[d][i] * ss[i] * g); }
        }
    } else {
        attn_pass<3, 0, 8>(lds, P, 3, b, hd, qb, qb * 256, 4 * (qb + 1), wid, o, ltot, 0u, sc128);
        store_o(P, o, 3, b, hd, qb);
    }
}
#undef MFMA32
}

#define LAS __attribute__((address_space(3)))
typedef unsigned short bf16;
typedef unsigned v4u __attribute__((ext_vector_type(4)));
typedef float f32x4 __attribute__((ext_vector_type(4)));
constexpr size_t MiB = 1u << 20;
constexpr size_t WS_CTL = 0, CTL_ZERO_BYTES = 65536;
constexpr int CW_BAR = 4096, MISC_OFF = 131072;
constexpr size_t WS_WIN = 1 * MiB, WS_WOUT = 25 * MiB, WS_WGU = 33 * MiB, WS_WDN = 77 * MiB;
constexpr size_t WS_X = 100 * MiB, WS_H = 164 * MiB, WS_Z = 196 * MiB, WS_VT = 292 * MiB, WS_MIX = 324 * MiB, WS_ACT = 356 * MiB;
constexpr size_t WS_LF = 444 * MiB, WS_CF = 445 * MiB, WS_KP = 446 * MiB, WS_COSF = 447 * MiB, WS_SINF = 448 * MiB, WS_COSH = 449 * MiB, WS_SINH = 450 * MiB, WS_SSQ = 451 * MiB, WS_RSTD = 452 * MiB, WS_END = 453 * MiB;
constexpr int LDS_BYTES = 131072 + 8192;
static_assert(att::L_END <= 131072, "attention LDS map");
constexpr int NPHASE = 25;

struct Params {
    const float* x; const float* w_in; const float* b_fgate; const float* w_out; const float* lq1; const float* lk1; const float* lq2; const float* lk2;
    const float* subln; const float* attn_norm; const float* w_gate; const float* w_up; const float* w_down; const float* ffn_norm; const float* final_norm;
    float* out; unsigned char* ws;
    float lam_init[4]; float inv_full[64]; float inv_half[32];
    int ph_lo, ph_hi;
};

DI float wave_sum(float v) {
#pragma unroll
    for (int o = 1; o < 64; o <<= 1) v += __shfl_xor(v, o);
    return v;
}
DI unsigned pk2(float lo, float hi) { return pg8::cvtpk(lo, hi); }

DI void transpose_item(const float* W, int ldw, bf16* WT, int K, LAS float* scr, int k0, int lane) {
#pragma unroll
    for (int i = 0; i < 32; ++i) { const int kk = 2 * i + (lane >> 5); scr[kk * 33 + (lane & 31)] = __builtin_nontemporal_load(W + (size_t)(k0 + kk) * ldw + (lane & 31)); }
    asm volatile("s_waitcnt lgkmcnt(0)" ::: "memory");
    const int c = lane & 7;
#pragma unroll
    for (int j = 0; j < 4; ++j) { const int n = (lane >> 3) + 8 * j; const LAS float* s = scr + (8 * c) * 33 + n;
        v4u o; o.x = pk2(s[0 * 33], s[1 * 33]); o.y = pk2(s[2 * 33], s[3 * 33]); o.z = pk2(s[4 * 33], s[5 * 33]); o.w = pk2(s[6 * 33], s[7 * 33]);
        *(v4u*)(WT + (size_t)n * K + k0 + 8 * c) = o; }
    asm volatile("s_waitcnt lgkmcnt(0)" ::: "memory");
}

DI void convert_weights(const Params& p, int l, LAS unsigned char* lds, int gw, int NGW, int wave, int lane) {
    LAS float* scr = (LAS float*)(lds + wave * 16384);
    bf16* win = (bf16*)(p.ws + WS_WIN); bf16* wout = (bf16*)(p.ws + WS_WOUT); bf16* wgu = (bf16*)(p.ws + WS_WGU); bf16* wdn = (bf16*)(p.ws + WS_WDN);
    constexpr int I_IN = 32 * 192, I_OUT = 32 * 64, I_GU = 32 * 352, I_DN = 88 * 64, NIT = I_IN + I_OUT + I_GU + I_DN;
    for (int it = gw; it < NIT; it += NGW) {
        int r = it;
        if (r < I_IN) {
            const int kb = r / 192, nb = r - kb * 192, j0 = 32 * nb, region = j0 >> 9, within = j0 & 511, t256 = within >> 8, T0 = within & 255;
            const int sT = (region == 3 || region == 4) ? ((T0 & 0x3F) | ((T0 & 0x40) << 1) | ((T0 & 0x80) >> 1)) : ((region == 6 || region == 7) ? ((T0 & 0x5F) | ((T0 & 0x20) << 2) | ((T0 & 0x80) >> 2)) : T0);
            const int src = region * 512 + (region >= 3 ? 4 : 0) + t256 * 256 + sT;
            transpose_item(p.w_in + (size_t)l * DM * WIN_LD + src, WIN_LD, win + (size_t)j0 * DM, DM, scr, 64 * kb, lane); continue; }
        r -= I_IN;
        if (r < I_OUT) { const int kb = r / 64, nb = r - kb * 64, j0 = 32 * nb;
            transpose_item(p.w_out + (size_t)l * DM * DM + j0, DM, wout + (size_t)j0 * DM, DM, scr, 64 * kb, lane); continue; }
        r -= I_OUT;
        if (r < I_GU) { const int kb = r / 352, nb = r - kb * 352, j0 = 32 * nb, pn = j0 >> 8, bj = (j0 >> 7) & 1, i0 = j0 & 127;
            const float* src = (bj ? p.w_up : p.w_gate) + (size_t)l * DM * FF + 128 * pn + i0;
            transpose_item(src, FF, wgu + (size_t)j0 * DM, DM, scr, 64 * kb, lane); continue; }
        r -= I_GU;
        { const int kb = r / 64, nb = r - kb * 64, j0 = 32 * nb;
            transpose_item(p.w_down + (size_t)l * FF * DM + j0, DM, wdn + (size_t)j0 * FF, FF, scr, 64 * kb, lane); }
    }
}

DI void sincos_d(double x, double& s, double& c) {
    const double kd = rint(x * 0.63661977236758134308);
    const int k = (int)kd;
    double rr = fma(-kd, 1.57079632679489655800e+00, x); rr = fma(-kd, 6.12323399573676603587e-17, rr);
    const double r2 = rr * rr;
    const double sp = rr * (1.0 + r2 * (-1.0 / 6 + r2 * (1.0 / 120 + r2 * (-1.0 / 5040 + r2 * (1.0 / 362880 + r2 * (-1.0 / 39916800 + r2 * (1.0 / 6227020800.0 + r2 * (-1.0 / 1307674368000.0))))))));
    const double cp = 1.0 + r2 * (-0.5 + r2 * (1.0 / 24 + r2 * (-1.0 / 720 + r2 * (1.0 / 40320 + r2 * (-1.0 / 3628800 + r2 * (1.0 / 479001600.0 + r2 * (-1.0 / 87178291200.0 + r2 * (1.0 / 20922789888000.0))))))));
    const int q = k & 3;
    s = (q == 0) ? sp : (q == 1) ? cp : (q == 2) ? -sp : -cp;
    c = (q == 0) ? cp : (q == 1) ? -sp : (q == 2) ? -cp : sp;
}
DI void rope_tables(const Params& p, int gtid, int gthreads) {
    float* cF = (float*)(p.ws + WS_COSF); float* sF = (float*)(p.ws + WS_SINF); float* cH = (float*)(p.ws + WS_COSH); float* sH = (float*)(p.ws + WS_SINH);
    for (int i = gtid; i < SEQ * 96; i += gthreads) {
        const int pos = i / 96, j = i - pos * 96;
        const float inv = (j < 64) ? p.inv_full[j] : p.inv_half[j - 64];
        const float ang = (float)pos * inv;
        double s, c; sincos_d((double)ang, s, c);
        if (j < 64) { cF[pos * 64 + j] = (float)c; sF[pos * 64 + j] = (float)s; } else { cH[pos * 32 + j - 64] = (float)c; sH[pos * 32 + j - 64] = (float)s; }
    }
}

template <bool OUTF32, bool COPY, bool FG>
DI void rms_row(const float* xrow, const float* g, void* orow, float* xcopy, const LAS f32x4* wfg, f32x4& fgacc, int lane) {
    const f32x4* xr = (const f32x4*)xrow + lane;
    f32x4 v[8]; float ss = 0.f;
#pragma unroll
    for (int j = 0; j < 8; ++j) { v[j] = xr[64 * j]; ss += (v[j].x * v[j].x + v[j].y * v[j].y) + (v[j].z * v[j].z + v[j].w * v[j].w); }
    const float rstd = 1.0f / sqrtf(wave_sum(ss) * (1.0f / DM) + 1e-6f);
    f32x4 fa = {0.f, 0.f, 0.f, 0.f};
#pragma unroll
    for (int j = 0; j < 8; ++j) {
        if (COPY) ((f32x4*)xcopy)[64 * j + lane] = v[j];
        const f32x4 gg = ((const f32x4*)g)[64 * j + lane];
        const f32x4 y = v[j] * rstd * gg;
        if (OUTF32) ((f32x4*)orow)[64 * j + lane] = y;
        else { unsigned long long w = (unsigned long long)pk2(y.x, y.y) | ((unsigned long long)pk2(y.z, y.w) << 32); ((unsigned long long*)orow)[64 * j + lane] = w; }
        if (FG) { const int k = 4 * (64 * j + lane); fa += y.x * wfg[k] + y.y * wfg[k + 1] + y.z * wfg[k + 2] + y.w * wfg[k + 3]; }
    }
    fgacc = fa;
}

#define XB_TMO      128
#define XB_XCNT(j)  (256  + 64 * (j))
#define XB_XSUB(j)  (1280 + 64 * (j))
#define XB_XGEN(j)  (2304 + 64 * (j))
#define XB_TOP      3328
#define XB_TOPGEN   3392
#define XCD_BAR_WORDS 3456
#define XB_SPIN_CAP (1u << 18)

__device__ __forceinline__ unsigned xb_ld(unsigned* p)              { return __hip_atomic_load(p, __ATOMIC_RELAXED, __HIP_MEMORY_SCOPE_AGENT); }
__device__ __forceinline__ unsigned xb_add(unsigned* p, unsigned v) { return __hip_atomic_fetch_add(p, v, __ATOMIC_RELAXED, __HIP_MEMORY_SCOPE_AGENT); }
__device__ __forceinline__ unsigned xb_xcc_id() { return (unsigned)__builtin_amdgcn_s_getreg((3 << 11) | 20) & 0xFu; }
#define XB_SPIN(cond, bar) do { unsigned _sp = 0; while (cond) { __builtin_amdgcn_s_sleep(1); \
    if ((++_sp & 255u) == 0u) { if (xb_ld(&(bar)[XB_TMO])) break; if (_sp > XB_SPIN_CAP) { atomicAdd(&(bar)[XB_TMO], 1u); break; } } } } while (0)

struct XcdBarrier {
    unsigned* bar; unsigned x;
    volatile LAS unsigned* st;
};

__device__ __forceinline__ XcdBarrier xcd_barrier_post(unsigned* bar, volatile LAS unsigned* st) {
    XcdBarrier b; b.bar = bar; b.x = xb_xcc_id(); b.st = st;
    if (threadIdx.x == 0) (void)xb_add(&bar[XB_XCNT(b.x)], 1u);
    return b;
}
__device__ __forceinline__ void xcd_barrier_complete(unsigned* bar, unsigned x, unsigned& nloc, unsigned& nx) {
    const unsigned G = gridDim.x * gridDim.y * gridDim.z;
    unsigned sum, cnt, mine, sp = 0u;
    for (;;) {
        sum = 0u; cnt = 0u; mine = 0u;
#pragma unroll
        for (unsigned j = 0; j < 16; ++j) { const unsigned c = xb_ld(&bar[XB_XCNT(j)]); sum += c; cnt += (c > 0u) ? 1u : 0u; mine = (j == x) ? c : mine; }
        if (sum == G) break;
        __builtin_amdgcn_s_sleep(1);
        if ((++sp & 255u) == 0u) { if (xb_ld(&bar[XB_TMO])) break; if (sp > XB_SPIN_CAP) { atomicAdd(&bar[XB_TMO], 1u); break; } }
    }
    nloc = mine > 0u ? mine : 1u; nx = cnt > 0u ? cnt : 1u;
}

__device__ __forceinline__ void xcd_barrier(const XcdBarrier& b) {
    asm volatile("s_waitcnt vmcnt(0)" ::: "memory");
    __syncthreads();
    if (threadIdx.x == 0) {
        unsigned* bar = b.bar;
        __builtin_amdgcn_s_waitcnt(0);
        unsigned nloc = b.st[0], nx = b.st[1];
        if (nloc == 0u) { xcd_barrier_complete(bar, b.x, nloc, nx); b.st[0] = nloc; b.st[1] = nx; }
        const unsigned old = xb_add(&bar[XB_XSUB(b.x)], 1u);
        const unsigned gen = old / nloc;
        if (old + 1u == (gen + 1u) * nloc) {
            __builtin_amdgcn_fence(__ATOMIC_RELEASE, "agent");
            asm volatile("s_waitcnt vmcnt(0)" ::: "memory");
            const unsigned og = xb_add(&bar[XB_TOP], 1u);
            const unsigned tg = og / nx;
            if (og + 1u == (tg + 1u) * nx) xb_add(&bar[XB_TOPGEN], 1u);
            else XB_SPIN(xb_ld(&bar[XB_TOPGEN]) == tg, bar);
            __builtin_amdgcn_fence(__ATOMIC_ACQUIRE, "agent");
            xb_add(&bar[XB_XGEN(b.x)], 1u);
            asm volatile("s_waitcnt vmcnt(0)" ::: "memory");
        } else {
            XB_SPIN(xb_ld(&bar[XB_XGEN(b.x)]) == gen, bar);
            __builtin_amdgcn_fence(__ATOMIC_ACQUIRE, "agent");
            asm volatile("s_waitcnt vmcnt(0)" ::: "memory");
        }
    }
    __syncthreads();
}

DI void post_phase(bf16* zb, bf16* vT, unsigned char* ws, LAS unsigned char* lds, int bx, int G, int tid, unsigned* kmax2) {
    typedef short s16x8 __attribute__((ext_vector_type(8)));
    const float* cosF = (const float*)(ws + WS_COSF); const float* sinF = (const float*)(ws + WS_SINF);
    const float* cosH = (const float*)(ws + WS_COSH); const float* sinH = (const float*)(ws + WS_SINH);
    for (int task = bx * 512 + tid; task < M_TOK * 128; task += G * 512) {
        const int row = task >> 7, j = task & 127, pos = row & 2047;
        int c1, c2; unsigned to; const float* ct; const float* st;
        if (j < 64) { const int i0 = (j & 7) * 8; c1 = 1536 + (j >> 3) * 128 + i0; c2 = c1 + 64; to = (unsigned)(pos * 64 + i0); ct = cosF; st = sinF; }
        else { const int jj = j - 64, i0 = (jj & 3) * 8; c1 = 3072 + (jj >> 2) * 64 + i0; c2 = c1 + 32; to = (unsigned)(pos * 32 + i0); ct = cosH; st = sinH; }
        bf16* zr = zb + (size_t)row * ZC;
        const s16x8 a = *(const s16x8*)(zr + c1), b2 = *(const s16x8*)(zr + c2);
        const f32x4 ca = *(const f32x4*)(ct + to), cb = *(const f32x4*)(ct + to + 4), sa = *(const f32x4*)(st + to), sb = *(const f32x4*)(st + to + 4);
        float y1[8], y2[8];
#pragma unroll
        for (int e = 0; e < 8; ++e) { const float x1 = att::bf2f(a[e]), x2 = att::bf2f(b2[e]); const float c = (e < 4) ? ca[e & 3] : cb[e & 3], s = (e < 4) ? sa[e & 3] : sb[e & 3];
            y1[e] = x1 * c - x2 * s; y2[e] = x2 * c + x1 * s; }
        v4u w1, w2;
        w1.x = pk2(y1[0], y1[1]); w1.y = pk2(y1[2], y1[3]); w1.z = pk2(y1[4], y1[5]); w1.w = pk2(y1[6], y1[7]);
        w2.x = pk2(y2[0], y2[1]); w2.y = pk2(y2[2], y2[3]); w2.z = pk2(y2[4], y2[5]); w2.w = pk2(y2[6], y2[7]);
        *(v4u*)(zr + c1) = w1; *(v4u*)(zr + c2) = w2;
    }
    const int lane = tid & 63, wave = tid >> 6;
    for (int chunk = bx; chunk < M_TOK / 32; chunk += G) {
        float mx0 = 0.f, mx1 = 0.f, mx2 = 0.f, mx3 = 0.f;
#pragma unroll
        for (int i = 0; i < 4; ++i) {
            const int row = chunk * 32 + wave * 4 + i;
            const bf16* kr = zb + (size_t)row * ZC + 512 + 2 * lane;
#pragma unroll
            for (int head = 0; head < 4; ++head) {
                const unsigned w = *(const unsigned*)(kr + head * 128);
                const float a = __uint_as_float(w << 16), b2 = __uint_as_float(w & 0xffff0000u);
                const float ss = wave_sum(a * a + b2 * b2);
                if (head == 0) mx0 = fmaxf(mx0, ss); else if (head == 1) mx1 = fmaxf(mx1, ss); else if (head == 2) mx2 = fmaxf(mx2, ss); else mx3 = fmaxf(mx3, ss);
            }
        }
        volatile LAS float* red = (volatile LAS float*)(lds + 8 * 9216);
        __syncthreads();
        if (lane == 0) { red[wave * 4 + 0] = mx0; red[wave * 4 + 1] = mx1; red[wave * 4 + 2] = mx2; red[wave * 4 + 3] = mx3; }
        __syncthreads();
        if (tid < 4) { float m = 0.f;
#pragma unroll
            for (int w8 = 0; w8 < 8; ++w8) m = fmaxf(m, red[w8 * 4 + tid]);
            atomicMax(kmax2 + ((chunk * 32) >> 11) * 4 + tid, __float_as_uint(m)); }
    }
    __syncthreads();
}

__constant__ unsigned char g_unit_order[40] = {7, 15, 6, 14, 23, 39, 5, 13, 22, 38, 4, 12, 21, 37, 3, 11, 20, 36, 2, 10, 19, 35, 18, 34, 1, 9, 17, 33, 0, 8, 16, 32, 31, 30, 29, 28, 27, 26, 25, 24};
DI void diff_combine(const float* dA, const float* dB, bf16* mixed, const float* gsub, const float* lq1, const float* lk1, const float* lq2, const float* lk2, float lam_init, int gw, int NGW, int lane) {
    float d1 = lq1[lane] * lk1[lane], d2 = lq2[lane] * lk2[lane];
    d1 = wave_sum(d1); d2 = wave_sum(d2);
    const float lam = expf(d1) - expf(d2) + lam_init;
    const float g0 = gsub[2 * lane] * (1.0f - lam_init), g1 = gsub[2 * lane + 1] * (1.0f - lam_init);
    for (int t = gw; t < M_TOK * 4; t += NGW) {
        typedef float f32x2v __attribute__((ext_vector_type(2)));
        const f32x2v a = *(const f32x2v*)(dA + (size_t)t * 128 + 2 * lane), b2 = *(const f32x2v*)(dB + (size_t)t * 128 + 2 * lane);
        const float v0 = a.x - lam * b2.x, v1 = a.y - lam * b2.y;
        const float ss = wave_sum(v0 * v0 + v1 * v1);
        const float rs = 1.0f / sqrtf(ss * (1.0f / 128.0f) + 1e-5f);
        const int row = t >> 2, head = t & 3;
        *(unsigned*)(mixed + (size_t)row * DM + 1024 + head * 128 + 2 * lane) = pk2(v0 * rs * g0, v1 * rs * g1);
    }
}

__global__ void __launch_bounds__(512, 2) fwd_kernel(Params p) {
    extern __shared__ __attribute__((aligned(16))) unsigned char lds[];
    cg::grid_group grid = cg::this_grid();
    { volatile LAS unsigned* misc = (volatile LAS unsigned*)((LAS unsigned char*)lds + MISC_OFF); if (threadIdx.x < 16) misc[threadIdx.x] = 0u; }
    __syncthreads();
    XcdBarrier bar = xcd_barrier_post((unsigned*)(p.ws + WS_CTL) + CW_BAR, (volatile LAS unsigned*)((LAS unsigned char*)lds + MISC_OFF) + 8);
    if (p.ph_lo == 0) rope_tables(p, (int)(blockIdx.x * 512 + threadIdx.x), (int)(gridDim.x * 512));
    for (int ph = p.ph_lo; ph < p.ph_hi; ++ph) {
        if (ph == p.ph_lo + 1) grid.sync();
        else if (ph > p.ph_lo) xcd_barrier(bar);
        const int tid = tid_opaque(), lane = tid & 63, wave = __builtin_amdgcn_readfirstlane(tid >> 6);
        int G = gridDim.x, bx = blockIdx.x; size_t wsoff = 0;
        asm volatile("" : "+s"(G), "+s"(bx), "+s"(wsoff));
        unsigned char* ws = p.ws + wsoff;
        const int gw = bx * 8 + wave, NGW = G * 8;
        LAS unsigned char* ldsl = (LAS unsigned char*)lds;
        bf16* win = (bf16*)(ws + WS_WIN); bf16* wout = (bf16*)(ws + WS_WOUT); bf16* wgu = (bf16*)(ws + WS_WGU); bf16* wdn = (bf16*)(ws + WS_WDN);
        float* xres = (float*)(ws + WS_X); bf16* hb = (bf16*)(ws + WS_H); bf16* zb = (bf16*)(ws + WS_Z); bf16* vT = (bf16*)(ws + WS_VT);
        bf16* mixed = (bf16*)(ws + WS_MIX); bf16* act = (bf16*)(ws + WS_ACT);
        float* lf = (float*)(ws + WS_LF); float* cf = (float*)(ws + WS_CF);
        unsigned* ctl = (unsigned*)(ws + WS_CTL);
        if (ph == NPHASE - 1) {
            f32x4 dummy;
            for (int m = gw; m < M_TOK; m += NGW) rms_row<true, false, false>(xres + (size_t)m * DM, p.final_norm, p.out + (size_t)m * DM, nullptr, nullptr, dummy, lane);
            continue;
        }
        const int l = ph / 6; int k = ph - 6 * l;
        if (k >= 4) ++k;
        if (k == 0) {
            convert_weights(p, l, ldsl, gw, NGW, wave, lane);
            __syncthreads();
            LAS f32x4* wfg = (LAS f32x4*)ldsl;
            const float* wl = p.w_in + (size_t)l * DM * WIN_LD + 1536;
            for (int kk = tid; kk < DM; kk += 512) wfg[kk] = *(const f32x4*)(wl + (size_t)kk * WIN_LD);
            __syncthreads();
            const float* xs = (l == 0) ? p.x : xres;
            const f32x4 bias = *(const f32x4*)(p.b_fgate + 4 * l);
            for (int m = gw; m < M_TOK; m += NGW) {
                f32x4 fa;
                rms_row<false, false, true>(xs + (size_t)m * DM, p.attn_norm + l * DM, hb + (size_t)m * DM, nullptr, wfg, fa, lane);
                fa.x = wave_sum(fa.x); fa.y = wave_sum(fa.y); fa.z = wave_sum(fa.z); fa.w = wave_sum(fa.w);
                if (lane < 4) {
                    const float v = (lane == 0 ? fa.x + bias.x : lane == 1 ? fa.y + bias.y : lane == 2 ? fa.z + bias.z : fa.w + bias.w);
                    const float ls = fminf(v, 0.f) - log1pf(expf(-fabsf(v)));
                    const int b = m >> 11, t = m & 2047;
                    lf[(b * 4 + lane) * SEQ + t] = ls;
                }
            }
            __syncthreads();
        } else if (k == 1) {
            if (bx < 16 && wave == 0) {
                const float* src = lf + bx * SEQ + 32 * lane; float* dst = cf + bx * SEQ + 32 * lane;
                float v[32]; float run = 0.f;
#pragma unroll
                for (int i = 0; i < 32; ++i) { v[i] = src[i]; run += v[i]; }
                float tot = run;
#pragma unroll
                for (int o = 1; o < 64; o <<= 1) { const float t = __shfl_up(tot, o); if (lane >= o) tot += t; }
                float accv = tot - run;
#pragma unroll
                for (int i = 0; i < 32; ++i) { accv += v[i]; dst[i] = accv; }
            }
            pg8::Gemm g{hb, win, M_TOK, ZC, DM}; pg8::StaticOrder S; S.init(M_TOK, ZC, G, bx);
            pg8::EpiZ E{zb, (const float*)(ws + WS_COSF), (const float*)(ws + WS_SINF), (const float*)(ws + WS_COSH), (const float*)(ws + WS_SINH), ctl + 2304 + 16 * l};
            pg8::gemm_phase<pg8::EpiZ, pg8::StaticOrder, true, true>(ldsl, g, S, E);
        } else if (k == 2) {
            att::AttnP AP{zb, vT, mixed, (float*)(ws + WS_ACT), (float*)(ws + WS_ACT + 16 * MiB), cf, (const unsigned*)(ctl + 2304 + 16 * l), p.subln + l * 128, p.lq1 + l * 64, p.lk1 + l * 64, p.lq2 + l * 64, p.lk2 + l * 64, p.lam_init[l]};
            volatile unsigned* shu = (volatile unsigned*)(lds + att::L_UNIT);
            const int myx = (int)(bar.x & 7u);
            for (;;) {
                __syncthreads();
                if (tid == 0) {
                    unsigned got = 0xffffffffu;
                    for (int kq = 0; kq < 8; ++kq) { const int xq = (myx + kq) & 7; const unsigned v = atomicAdd(ctl + 64 * (l * 8 + xq), 1u); if (v < 80u) { got = (unsigned)xq * 80u + v; break; } }
                    *shu = got;
                }
                __syncthreads();
                const unsigned u = *shu;
                if (u == 0xffffffffu) break;
                const unsigned xq = u / 80u, v = u - xq * 80u;
                const int e = g_unit_order[v >> 1];
                att::attn_unit(lds, AP, e >> 3, (int)(2u * xq + (v & 1u)), e & 7);
            }
        } else if (k == 3) {
            pg8::Gemm g{mixed, wout, M_TOK, DM, DM}; pg8::StaticOrder S; S.init(M_TOK, DM, G, bx);
            pg8::EpiResN E{(l == 0) ? p.x : (const float*)xres, xres, hb, p.ffn_norm + l * DM, (float*)(ws + WS_SSQ)};
            pg8::gemm_phase<pg8::EpiResN, pg8::StaticOrder, false, true>(ldsl, g, S, E);
        } else if (k == 5) {
            pg8::Gemm g{hb, wgu, M_TOK, 2 * FF, DM}; pg8::StaticOrder S; S.init(M_TOK, 2 * FF, G, bx);
            float* rstd = (float*)(ws + WS_RSTD); const float* ssq = (const float*)(ws + WS_SSQ);
            {
                pg8::Unit uu;
                for (int i = 0; S.next(i, uu); ++i) if (tid < 256) {
                    const int row = uu.pm * 256 + tid; const f32x4* sp = (const f32x4*)(ssq + (size_t)row * 32); float s = 0.f;
#pragma unroll
                    for (int j = 0; j < 8; ++j) { const f32x4 v = sp[j]; s += (v.x + v.y) + (v.z + v.w); }
                    rstd[row] = 1.0f / sqrtf(s * (1.0f / DM) + 1e-6f); }
                asm volatile("s_waitcnt vmcnt(0)" ::: "memory");
                __syncthreads();
            }
            pg8::EpiSwiR E{act, rstd};
            pg8::gemm_phase<pg8::EpiSwiR, pg8::StaticOrder, true, true>(ldsl, g, S, E);
        } else {
            pg8::Gemm g{act, wdn, M_TOK, DM, FF}; pg8::StaticOrder S; S.init(M_TOK, DM, G, bx);
            pg8::EpiRes E{xres};
            pg8::gemm_phase<pg8::EpiRes, pg8::StaticOrder, false, true>(ldsl, g, S, E);
        }
    }
}

#ifndef MK_MULTI
#define MK_MULTI 0
#endif
extern "C" void kernel_launch(void* const* d_in, const int* in_sizes, int n_in, void* d_out, int out_size, void* d_ws, size_t ws_size, hipStream_t stream) {
    static int grid = 0;
    if (grid == 0) {
        if (n_in != 15 || in_sizes[0] != M_TOK * DM || out_size != M_TOK * DM || ws_size < WS_END) { fprintf(stderr, "kernel_launch: unexpected shapes (n_in %d, ws %zu)\n", n_in, ws_size); grid = -1; return; }
        int dev = 0, cus = 0, per_cu = 0;
        hipGetDevice(&dev); hipDeviceGetAttribute(&cus, hipDeviceAttributeMultiprocessorCount, dev);
        if (hipFuncSetAttribute((const void*)fwd_kernel, hipFuncAttributeMaxDynamicSharedMemorySize, LDS_BYTES) != hipSuccess) { fprintf(stderr, "kernel_launch: hipFuncSetAttribute failed\n"); grid = -1; return; }
        if (hipOccupancyMaxActiveBlocksPerMultiprocessor(&per_cu, (const void*)fwd_kernel, 512, LDS_BYTES) != hipSuccess || per_cu < 1) { fprintf(stderr, "kernel_launch: occupancy query says %d\n", per_cu); per_cu = 1; }
        (void)hipGetLastError();
        grid = cus * per_cu;
    }
    if (grid < 0) return;
    hipMemsetAsync((char*)d_ws + WS_CTL, 0, CTL_ZERO_BYTES, stream);
    Params p{};
    p.x = (const float*)d_in[0]; p.w_in = (const float*)d_in[1]; p.b_fgate = (const float*)d_in[2]; p.w_out = (const float*)d_in[3];
    p.lq1 = (const float*)d_in[4]; p.lk1 = (const float*)d_in[5]; p.lq2 = (const float*)d_in[6]; p.lk2 = (const float*)d_in[7];
    p.subln = (const float*)d_in[8]; p.attn_norm = (const float*)d_in[9]; p.w_gate = (const float*)d_in[10]; p.w_up = (const float*)d_in[11];
    p.w_down = (const float*)d_in[12]; p.ffn_norm = (const float*)d_in[13]; p.final_norm = (const float*)d_in[14];
    p.out = (float*)d_out; p.ws = (unsigned char*)d_ws;
    for (int l = 0; l < 4; ++l) p.lam_init[l] = (float)(0.8 - 0.6 * std::exp(-0.3 * (double)l));
    for (int i = 0; i < 64; ++i) p.inv_full[i] = (float)(1.0 / std::pow(10000.0, (double)(2 * i) / 128.0));
    for (int i = 0; i < 32; ++i) p.inv_half[i] = (float)(1.0 / std::pow(10000.0, (double)(2 * i) / 64.0));
#if MK_MULTI
    for (int ph = 0; ph < NPHASE; ++ph) { p.ph_lo = ph; p.ph_hi = ph + 1; hipLaunchKernelGGL(fwd_kernel, dim3(grid), dim3(512), LDS_BYTES, stream, p); }
#else
    p.ph_lo = 0; p.ph_hi = NPHASE;
    void* args[] = {&p};
    hipError_t e = hipLaunchCooperativeKernel((const void*)fwd_kernel, dim3(grid), dim3(512), args, LDS_BYTES, stream);
    if (e != hipSuccess) fprintf(stderr, "cooperative launch failed: %s (grid %d)\n", hipGetErrorString(e), grid);
#endif
}
```
